# Optimizing an MI355X kernel written in HIP

```python
import math
import jax, jax.numpy as jnp
from jax import lax
import numpy as np

D_MODEL = 1024
BATCH = 4
SEQ = 8192
DEPTH = 2

N_MIXERS = 2
N_CONV_LAYERS = (DEPTH + 1) // 2
N_ATTN_LAYERS = DEPTH // 2
D_FF = 2816
CONV_WIDTH = 3
HEAD_DIM = 64
N_HEADS = D_MODEL // HEAD_DIM
DILATION_GROUPS = ((128, 1), (512, 4), (2048, 16))
N_GROUPS = len(DILATION_GROUPS)
BLOCK = 128
N_BUCKETS = 32
MAX_EXACT = N_BUCKETS // 2
MAX_DISTANCE = 2048
RMS_EPS = 1e-6
NEG_INF = -1e30

kernel_name = "hybrid_shortconv_dilated_swa_macaron"


def rmsnorm(x, g):
    xf = x.astype(jnp.float32)
    y = xf * lax.rsqrt(jnp.mean(xf * xf, axis=-1, keepdims=True) + RMS_EPS) * g.astype(jnp.float32)
    return y.astype(x.dtype)


def swiglu(h, w_in, w_out):
    gate, up = jnp.split(h @ w_in, 2, axis=-1)
    return (jax.nn.silu(gate) * up) @ w_out


def short_conv_mixer(h, w_in, w_conv, w_out):
    b_gate, c_gate, u = jnp.split(h @ w_in, 3, axis=-1)
    v = c_gate * u
    T = v.shape[1]
    vp = jnp.pad(v, ((0, 0), (CONV_WIDTH - 1, 0), (0, 0)))
    conv = sum(w_conv[lag] * vp[:, CONV_WIDTH - 1 - lag:CONV_WIDTH - 1 - lag + T]
               for lag in range(CONV_WIDTH))
    return (b_gate * conv) @ w_out


def t5_bucket(dist):
    is_small = dist < MAX_EXACT
    nf = jnp.maximum(dist, 1).astype(jnp.float32)
    large = MAX_EXACT + (jnp.log(nf / MAX_EXACT) / math.log(MAX_DISTANCE / MAX_EXACT)
                         * (N_BUCKETS - MAX_EXACT)).astype(jnp.int32)
    large = jnp.minimum(large, N_BUCKETS - 1)
    return jnp.where(is_small, dist, large)


def band_bias(rel_bias_g, dilation, n_steps):
    i = jnp.arange(BLOCK)[:, None]
    j = jnp.arange(2 * BLOCK)[None, :]
    step = BLOCK + i - j
    in_band = (step >= 0) & (step <= n_steps)
    bucket = t5_bucket(jnp.clip(step, 0, n_steps) * dilation)
    bias = rel_bias_g[bucket]
    return jnp.transpose(bias, (2, 0, 1)).astype(jnp.float32), in_band


def dilated_group(q, k, v, bias, in_band, dilation):
    B, T, H, Dh = q.shape
    span = dilation * BLOCK
    Tp = -(-T // span) * span
    L = Tp // dilation
    Lb = L // BLOCK

    def to_sub(a):
        a = jnp.pad(a, ((0, 0), (0, Tp - T), (0, 0), (0, 0))).reshape(B, L, dilation, H, Dh)
        return jnp.transpose(a, (0, 2, 1, 3, 4)).reshape(B, dilation, Lb, BLOCK, H, Dh)

    def with_prev(a):
        prev = jnp.pad(a, ((0, 0), (0, 0), (1, 0), (0, 0), (0, 0), (0, 0)))[:, :, :-1]
        return jnp.concatenate([prev, a], axis=3)

    qs = to_sub(q)
    kb = with_prev(to_sub(k))
    vb = with_prev(to_sub(v))
    logits = jnp.einsum('bsnqhd,bsnkhd->bsnhqk', qs, kb) + bias
    n_idx = jnp.arange(Lb)[:, None, None, None]
    j_idx = jnp.arange(2 * BLOCK)[None, None, None, :]
    valid = in_band[None, None] & ~((n_idx == 0) & (j_idx < BLOCK))
    logits = jnp.where(valid, logits, NEG_INF)
    m = jnp.max(logits, axis=-1, keepdims=True)
    p = jnp.exp(logits - m)
    s = jnp.sum(p, axis=-1, keepdims=True)
    o = jnp.einsum('bsnhqk,bsnkhd->bsnqhd', p, vb)
    o = o / jnp.transpose(s, (0, 1, 2, 4, 3, 5))
    lse = jnp.transpose((m + jnp.log(s))[..., 0], (0, 1, 2, 4, 3))

    def from_sub(a):
        rest = a.shape[4:]
        a = a.reshape((B, dilation, L) + rest)
        a = jnp.moveaxis(a, 1, 2).reshape((B, Tp) + rest)
        return a[:, :T]

    return from_sub(o), from_sub(lse)


def dilated_attention_mixer(h, w_qkv, q_gain, k_gain, w_out, rel_bias):
    B, T, _ = h.shape
    qkv = (h @ w_qkv).reshape(B, T, N_GROUPS, 3, N_HEADS, HEAD_DIM)
    outs, lses = [], []
    for g, (window, dilation) in enumerate(DILATION_GROUPS):
        q = rmsnorm(qkv[:, :, g, 0].astype(jnp.float32), q_gain[g]) * (HEAD_DIM ** -0.5)
        k = rmsnorm(qkv[:, :, g, 1].astype(jnp.float32), k_gain[g])
        v = qkv[:, :, g, 2].astype(jnp.float32)
        bias, in_band = band_bias(rel_bias[:, g * N_HEADS:(g + 1) * N_HEADS], dilation, window // dilation)
        o, lse = dilated_group(q, k, v, bias, in_band, dilation)
        outs.append(o)
        lses.append(lse)
    wts = jax.nn.softmax(jnp.stack(lses), axis=0)
    o = jnp.einsum('gbth,gbthd->bthd', wts, jnp.stack(outs))
    return o.reshape(B, T, N_HEADS * HEAD_DIM).astype(h.dtype) @ w_out


def setup_inputs(seed: int = 0) -> dict:
    key = jax.random.key(seed)
    ks = jax.random.split(key, 16)
    f32 = jnp.float32

    def w(k, shape, fan_in):
        return jax.random.normal(k, shape, f32) * (fan_in ** -0.5)

    def gain(k, shape):
        return 1.0 + 0.05 * jax.random.normal(k, shape, f32)

    return {
        "x": jax.random.normal(ks[0], (BATCH, SEQ, D_MODEL), f32),
        "norm_ffn1": gain(ks[1], (DEPTH, D_MODEL)),
        "ffn1_w_in": w(ks[2], (DEPTH, D_MODEL, 2 * D_FF), D_MODEL),
        "ffn1_w_out": w(ks[3], (DEPTH, D_FF, D_MODEL), D_FF),
        "norm_mix": gain(ks[4], (DEPTH, D_MODEL)),
        "conv_w_in": w(ks[5], (N_CONV_LAYERS, D_MODEL, 3 * D_MODEL), D_MODEL),
        "conv_w": w(ks[6], (N_CONV_LAYERS, CONV_WIDTH, D_MODEL), CONV_WIDTH),
        "conv_w_out": w(ks[7], (N_CONV_LAYERS, D_MODEL, D_MODEL), D_MODEL),
        "attn_w_qkv": w(ks[8], (N_ATTN_LAYERS, D_MODEL, N_GROUPS * 3 * N_HEADS * HEAD_DIM), D_MODEL),
        "attn_q_gain": gain(ks[9], (N_ATTN_LAYERS, N_GROUPS, HEAD_DIM)),
        "attn_k_gain": gain(ks[10], (N_ATTN_LAYERS, N_GROUPS, HEAD_DIM)),
        "attn_w_out": w(ks[11], (N_ATTN_LAYERS, N_HEADS * HEAD_DIM, D_MODEL), N_HEADS * HEAD_DIM),
        "rel_bias": 0.5 * jax.random.normal(ks[12], (N_BUCKETS, N_GROUPS * N_HEADS), f32),
        "norm_ffn2": gain(ks[13], (DEPTH, D_MODEL)),
        "ffn2_w_in": w(ks[14], (DEPTH, D_MODEL, 2 * D_FF), D_MODEL),
        "ffn2_w_out": w(ks[15], (DEPTH, D_FF, D_MODEL), D_FF),
    }


def reference(x, norm_ffn1, ffn1_w_in, ffn1_w_out, norm_mix, conv_w_in, conv_w, conv_w_out,
              attn_w_qkv, attn_q_gain, attn_k_gain, attn_w_out, rel_bias,
              norm_ffn2, ffn2_w_in, ffn2_w_out):
    h = x
    for i in range(DEPTH):
        h = h + 0.5 * swiglu(rmsnorm(h, norm_ffn1[i]), ffn1_w_in[i], ffn1_w_out[i])
        hn = rmsnorm(h, norm_mix[i])
        j = i // N_MIXERS
        if i % N_MIXERS == 0:
            mix = short_conv_mixer(hn, conv_w_in[j], conv_w[j], conv_w_out[j])
        else:
            mix = dilated_attention_mixer(hn, attn_w_qkv[j], attn_q_gain[j], attn_k_gain[j],
                                          attn_w_out[j], rel_bias)
        h = h + mix
        h = h + 0.5 * swiglu(rmsnorm(h, norm_ffn2[i]), ffn2_w_in[i], ffn2_w_out[i])
    return h
```

```cpp
#include <hip/hip_runtime.h>
#include <hip/hip_cooperative_groups.h>
#include <cstdio>
#include <cstdint>
namespace cg = cooperative_groups;

#ifndef MK_ONE_LAUNCH
#define MK_ONE_LAUNCH 1
#endif
#ifndef PROBE_STEP
#define PROBE_STEP (-1)
#endif
#ifndef PROBE_EPI2
#define PROBE_EPI2 0
#endif
#ifndef PROBE_REP
#define PROBE_REP 1
#endif

namespace pg8 {
#define PG8_LAS __attribute__((address_space(3)))
typedef unsigned short bf16_t;
typedef short bf16x8 __attribute__((ext_vector_type(8)));
typedef float f32x4 __attribute__((ext_vector_type(4)));
typedef unsigned u32x4 __attribute__((ext_vector_type(4)));
constexpr int BM = 256, BK = 64, HALF = 128, HTB = HALF * BK * 2, STAGE_BYTES = 8 * HTB, NXCD = 8, WGM = 8;

__host__ __device__ __forceinline__ int lds_byte(int r, int c) { const int st = (r >> 4) * 2 + (c >> 5), rr = r & 15, cc = c & 31, ob = rr * 64 + cc * 2; return st * 1024 + (ob ^ (((ob >> 9) & 1) << 5)); }
__host__ __device__ __forceinline__ void stage_rc(int b, int& R, int& C) { const int st = b / 1024, sb = b % 1024, swz = sb ^ (((sb >> 9) & 1) << 5); R = (st >> 1) * 16 + swz / 64; C = (st & 1) * 32 + (swz % 64) / 2; }
__host__ __device__ __forceinline__ int perm32(int rho) { const int n = rho >> 4, i = rho & 15; return 8 * (i >> 2) + 4 * n + (i & 3); }

struct Unit { int pm, pn; };
struct Gemm { const bf16_t* A; const bf16_t* Bt; int M, N, K; int lda_b; size_t kstepA; };

struct StaticOrder {
    int nM, nN, nwg, G, c;
    __host__ __device__ void init(int M, int N, int G_, int c_) { nM = M / BM; nN = N / BM; nwg = nM * nN; G = G_; c = c_; }
    __host__ __device__ bool next(int i, Unit& u) const {
        const long L = (long)i * G + c; if (L >= nwg) return false;
        int wgid = (int)L; { const int q = nwg / NXCD, r = nwg % NXCD, xcd = wgid % NXCD, off = wgid / NXCD; wgid = (xcd < r ? xcd * (q + 1) : r * (q + 1) + (xcd - r) * q) + off; }
        const int nig = WGM * nN, gid = wgid / nig, fm = gid * WGM, gsz = (nM - fm) < WGM ? (nM - fm) : WGM;
        u.pm = fm + ((wgid % nig) % gsz); u.pn = (wgid % nig) / gsz; return true;
    }
    __device__ __forceinline__ void a_ready(const Unit&) const {}
    __device__ __forceinline__ void done(const Unit&) const {}
};


struct PairOrder {
    int G, c;
    __host__ __device__ void init(int G_, int c_) { G = G_; c = c_; }
    __host__ __device__ bool next(int i, Unit& u) const {
        if (G != 256) { const long L = (long)i * G + c; if (L >= 512) return false; u.pm = (int)(L >> 2); u.pn = (int)(L & 3); return true; }
        if (i >= 2) return false;
        const int x = c & 7, j = c >> 3;
        u.pm = 32 * (x >> 1) + 16 * i + (j & 15); u.pn = 2 * (x & 1) + (j >> 4); return true;
    }
    __device__ __forceinline__ void a_ready(const Unit&) const {}
    __device__ __forceinline__ void done(const Unit&) const {}
};

__device__ __forceinline__ unsigned cvt_pk_bf16(float lo, float hi) { unsigned r; asm volatile("v_cvt_pk_bf16_f32 %0, %1, %2" : "=v"(r) : "v"(lo), "v"(hi)); return r; }

template <class Epi, class Sched, bool ALIGN_EPI = false, bool SP2 = false>
__device__ __forceinline__ void gemm_phase(PG8_LAS unsigned char* lds, const Gemm g, const Sched& S, const Epi& E) {
    int tid = threadIdx.x; asm volatile("" : "+v"(tid));
    const int wid = __builtin_amdgcn_readfirstlane(tid >> 6), lane = tid & 63, wr = wid >> 2, wc = wid & 3, fr0 = lane & 15, fq0 = lane >> 4;
    const int K = g.K, nt = K / BK;
    unsigned voffA[2], voffB[2];
#pragma unroll
    for (int i = 0; i < 2; ++i) { int R, C; stage_rc(tid * 16 + i * 8192, R, C); const int Rb = Epi::PERM ? ((R & ~31) + perm32(R & 31)) : R;
        voffA[i] = (unsigned)(R * g.lda_b + C * 2); voffB[i] = (unsigned)(Rb * K + C) * 2u; }
    const size_t kstepB = (size_t)(BK * 2), hstepB = (size_t)HALF * K * 2, tstepB = 2 * hstepB;
    const size_t kstepA = g.kstepA, hstepA = (size_t)HALF * g.lda_b, tstepA = 2 * hstepA;
    const unsigned ldsw = (unsigned)wid * 1024u;
    const int aoff = lds_byte(wr * 64 + fr0, fq0 * 8), boff = lds_byte(wc * 32 + fr0, fq0 * 8);
#define PG8_SA(b, h) (((b) * 2 + (h)) * HTB)
#define PG8_SB(b, h) ((4 + (b) * 2 + (h)) * HTB)
#define PG8_STAGE(bufoff, gbase, voff) do { _Pragma("unroll") for (int _i = 0; _i < 2; ++_i) \
        __builtin_amdgcn_global_load_lds((const unsigned*)((const char*)(gbase) + (voff)[_i]), (PG8_LAS unsigned*)(lds + (bufoff) + ldsw + _i * 8192), 16, 0, 0); } while (0)
#define PG8_LDA(dst, b, h) do { _Pragma("unroll") for (int m = 0; m < 4; ++m) _Pragma("unroll") for (int k = 0; k < 2; ++k) dst[m][k] = *(const PG8_LAS bf16x8*)(lds + PG8_SA(b, h) + aoff + m * 2048 + k * 1024); } while (0)
#define PG8_LDB(dst, b, h) do { _Pragma("unroll") for (int n = 0; n < 2; ++n) _Pragma("unroll") for (int k = 0; k < 2; ++k) dst[n][k] = *(const PG8_LAS bf16x8*)(lds + PG8_SB(b, h) + boff + n * 2048 + k * 1024); } while (0)
#define PG8_MMA(ai, bj, At, Bt) do { __builtin_amdgcn_s_setprio(1); _Pragma("unroll") for (int m = 0; m < 4; ++m) _Pragma("unroll") for (int n = 0; n < 2; ++n) _Pragma("unroll") for (int k = 0; k < 2; ++k) \
        acc[ai][bj][m][n] = __builtin_amdgcn_mfma_f32_16x16x32_bf16(Bt[n][k], At[m][k], acc[ai][bj][m][n], 0, 0, 0); __builtin_amdgcn_s_setprio(0); } while (0)
#define PG8_WAIT_V(n) asm volatile("s_waitcnt vmcnt(" #n ")" ::: "memory")
#define PG8_WAIT_L(n) asm volatile("s_waitcnt lgkmcnt(" #n ")" ::: "memory")
#define PG8_BAR __builtin_amdgcn_s_barrier()
#define PG8_SCHED __builtin_amdgcn_sched_barrier(0)
    Unit cur, nxt; int ui = 0;
    if (!S.next(0, cur)) return;
    int pmc0 = -1, pmc1 = -1, pmc2 = -1, pmc3 = -1;
    if constexpr (Epi::RSTD) {
        PG8_LAS float* rt = (PG8_LAS float*)(lds + STAGE_BYTES);
        Unit tu;
        for (int i = 0; S.next(i, tu); ++i) {
            const int p = tu.pm;
            if (p != pmc0 && p != pmc1 && p != pmc2 && p != pmc3) {
                int slot = -1;
                if (pmc0 < 0) { pmc0 = p; slot = 0; } else if (pmc1 < 0) { pmc1 = p; slot = 1; } else if (pmc2 < 0) { pmc2 = p; slot = 2; } else if (pmc3 < 0) { pmc3 = p; slot = 3; }
                if (slot >= 0 && tid < 256) rt[slot * 256 + tid] = E.rstd_global(p * 256 + tid);
            }
        }
    }
    f32x4 acc[2][2][4][2];
#pragma unroll
    for (int a = 0; a < 2; ++a)
#pragma unroll
        for (int b = 0; b < 2; ++b)
#pragma unroll
            for (int m = 0; m < 4; ++m)
#pragma unroll
                for (int n = 0; n < 2; ++n) acc[a][b][m][n] = (f32x4){0.f, 0.f, 0.f, 0.f};
    bf16x8 At[4][2], B0[2][2], B1[2][2];
    const char* cA = (const char*)g.A + (size_t)cur.pm * tstepA; const char* cB = (const char*)g.Bt + (size_t)cur.pn * tstepB;
    S.a_ready(cur);
    if constexpr (SP2) {
        PG8_STAGE(PG8_SB(0, 0), cB, voffB); PG8_STAGE(PG8_SB(0, 1), cB + hstepB, voffB); PG8_STAGE(PG8_SA(0, 0), cA, voffA); PG8_STAGE(PG8_SA(0, 1), cA + hstepA, voffA);
        if (wr == 1) PG8_BAR;
        PG8_WAIT_V(2); PG8_BAR;
        PG8_STAGE(PG8_SB(1, 0), cB + kstepB, voffB); PG8_STAGE(PG8_SA(1, 0), cA + kstepA, voffA); PG8_STAGE(PG8_SB(1, 1), cB + hstepB + kstepB, voffB);
        PG8_WAIT_V(6); PG8_BAR;
    } else {
        PG8_STAGE(PG8_SB(0, 0), cB, voffB); PG8_STAGE(PG8_SA(0, 0), cA, voffA); PG8_STAGE(PG8_SB(0, 1), cB + hstepB, voffB); PG8_STAGE(PG8_SA(0, 1), cA + hstepA, voffA);
        if (wr == 1) PG8_BAR;
        PG8_WAIT_V(4); PG8_BAR;
        PG8_STAGE(PG8_SB(1, 0), cB + kstepB, voffB); PG8_STAGE(PG8_SA(1, 0), cA + kstepA, voffA); PG8_STAGE(PG8_SB(1, 1), cB + hstepB + kstepB, voffB);
        PG8_WAIT_V(6); PG8_BAR;
    }
    for (;;) {
        const bool has_next = S.next(ui + 1, nxt);
        const char* nA = has_next ? (const char*)g.A + (size_t)nxt.pm * tstepA : cA; const char* nB = has_next ? (const char*)g.Bt + (size_t)nxt.pn * tstepB : cB;
#define PG8_ITER(W0) do { \
            PG8_LDB(B0, 0, 0); PG8_LDB(B1, 0, 1); PG8_SCHED; PG8_LDA(At, 0, 0); PG8_STAGE(PG8_SA(1, 1), a1 + hstepA, voffA); \
            asm volatile("s_waitcnt vmcnt(%0)" :: "n"(W0) : "memory"); PG8_WAIT_L(0); PG8_BAR; PG8_MMA(0, 0, At, B0); PG8_MMA(0, 1, At, B1); PG8_BAR; PG8_SCHED; \
            PG8_LDA(At, 0, 1); PG8_STAGE(PG8_SB(0, 0), b2, voffB); PG8_STAGE(PG8_SB(0, 1), b2 + hstepB, voffB); PG8_STAGE(PG8_SA(0, 0), a2, voffA); \
            asm volatile("s_waitcnt vmcnt(%0)" :: "n"(W0) : "memory"); PG8_WAIT_L(0); PG8_BAR; PG8_MMA(1, 0, At, B0); PG8_MMA(1, 1, At, B1); PG8_BAR; PG8_SCHED; \
            PG8_LDB(B0, 1, 0); PG8_LDB(B1, 1, 1); PG8_SCHED; PG8_LDA(At, 1, 0); PG8_STAGE(PG8_SA(0, 1), a2 + hstepA, voffA); \
            PG8_WAIT_V(8); PG8_WAIT_L(0); PG8_BAR; PG8_MMA(0, 0, At, B0); PG8_MMA(0, 1, At, B1); PG8_BAR; PG8_SCHED; \
            PG8_LDA(At, 1, 1); PG8_STAGE(PG8_SB(1, 0), b3, voffB); PG8_STAGE(PG8_SB(1, 1), b3 + hstepB, voffB); PG8_STAGE(PG8_SA(1, 0), a3, voffA); \
            PG8_WAIT_V(8); PG8_WAIT_L(0); PG8_BAR; PG8_MMA(1, 0, At, B0); PG8_MMA(1, 1, At, B1); PG8_BAR; PG8_SCHED; } while (0)
        if constexpr (Epi::PEEL) {
            const char* a1 = cA + kstepA; const char* a2 = cA + 2 * kstepA; const char* b2 = cB + 2 * kstepB; const char* a3 = a2 + kstepA; const char* b3 = b2 + kstepB;
            PG8_ITER(8);
        }
        for (int t = (Epi::PEEL ? 2 : 0); t < nt; t += 2) {
            const bool last = (t == nt - 2);
            const char* a1 = cA + (size_t)(t + 1) * kstepA;
            const char* a2 = last ? nA : cA + (size_t)(t + 2) * kstepA; const char* b2 = last ? nB : cB + (size_t)(t + 2) * kstepB;
            const char* a3 = a2 + kstepA; const char* b3 = b2 + kstepB;
            PG8_ITER(8);
        }
#undef PG8_ITER
        if constexpr (ALIGN_EPI) { if (wr == 0) PG8_BAR; }
        int tid2 = threadIdx.x; asm volatile("" : "+v"(tid2)); const int fr = tid2 & 15, fq = (tid2 & 63) >> 4;
        if constexpr (Epi::RSTD) {
            const int slot = cur.pm == pmc0 ? 0 : cur.pm == pmc1 ? 1 : cur.pm == pmc2 ? 2 : cur.pm == pmc3 ? 3 : -1;
            E(acc, cur, wr, wc, fr, fq, slot >= 0 ? (const PG8_LAS float*)(lds + STAGE_BYTES) + slot * 256 : (const PG8_LAS float*)nullptr);
        } else E(acc, cur, wr, wc, fr, fq);
#if PROBE_EPI2

#endif
        S.done(cur);
        if (!has_next) break;
#pragma unroll
        for (int a = 0; a < 2; ++a)
#pragma unroll
            for (int b = 0; b < 2; ++b)
#pragma unroll
                for (int m = 0; m < 4; ++m)
#pragma unroll
                    for (int n = 0; n < 2; ++n) acc[a][b][m][n] = (f32x4){0.f, 0.f, 0.f, 0.f};
        cur = nxt; cA = nA; cB = nB; ++ui;
        if constexpr (ALIGN_EPI) { if (wr == 1) PG8_BAR; }
    }
    PG8_WAIT_V(0);
    if constexpr (!ALIGN_EPI) { if (wr == 0) PG8_BAR; }
    PG8_BAR;
#undef PG8_SA
#undef PG8_SB
#undef PG8_STAGE
#undef PG8_LDA
#undef PG8_LDB
#undef PG8_MMA
#undef PG8_WAIT_V
#undef PG8_WAIT_L
#undef PG8_BAR
#undef PG8_SCHED
}
}

using pg8::bf16_t; using pg8::bf16x8; using pg8::f32x4; using pg8::u32x4; using pg8::Unit; using pg8::cvt_pk_bf16;
#define LAS __attribute__((address_space(3)))
#define GAS __attribute__((address_space(1)))
template <class T> __device__ __forceinline__ T gld(const void* p) { return *(const GAS T*)p; }
template <class T> __device__ __forceinline__ void gst(void* p, const T v) { *(GAS T*)p = v; }
typedef float f32x16 __attribute__((ext_vector_type(16)));
typedef short v4i16_t __attribute__((ext_vector_type(4)));

constexpr int BATCH = 4, SEQ = 8192, D = 1024, FF = 2816, M = BATCH * SEQ, NQKVG = 3072;
constexpr float RMS_EPS = 1e-6f, LOG2E = 1.4426950408889634f;
constexpr int NWAVES = 8, NTHREADS = 512;

constexpr size_t MiB = 1u << 20;
constexpr size_t WS_CTL = 0;
constexpr size_t WS_WFI = 2 * MiB;
constexpr size_t WFI_STRIDE = 11 * MiB;
constexpr size_t WS_WFO = 46 * MiB;
constexpr size_t WFO_STRIDE = (size_t)1024 * 2816 * 2;
constexpr size_t WS_WCI = 68 * MiB;
constexpr size_t WS_WCO = 74 * MiB;
constexpr size_t WS_WQKV = 76 * MiB;
constexpr size_t WS_WAO = 94 * MiB;
constexpr size_t WS_BIAS = 96 * MiB;
constexpr size_t WS_SSQ = 98 * MiB;
constexpr size_t SSQ_STRIDE = 2 * MiB;
constexpr size_t WS_LSE = 110 * MiB;
constexpr size_t WS_HB = 112 * MiB;
constexpr size_t WS_OB = 176 * MiB;
constexpr size_t WS_R1 = 240 * MiB;
constexpr size_t WS_END = 432 * MiB;

constexpr int KCS = 384 * 16 + 16, VHS = 384 * 64 + 64;
constexpr int A_K0 = 0, A_V0 = 8 * KCS, A_BT = A_V0 + 2 * VHS, A_WSF = A_BT + 768, A_OST = A_WSF + 2048, A_END = A_OST + 32768;
constexpr int LDS_BYTES = 140 * 1024, MISC_OFF = LDS_BYTES - 64;
static_assert(A_END <= MISC_OFF && pg8::STAGE_BYTES <= LDS_BYTES, "lds");

__device__ __forceinline__ unsigned f2bf(float f) { unsigned u = __builtin_bit_cast(unsigned, f); return (u + 0x7fffu + ((u >> 16) & 1u)) >> 16; }
__device__ __forceinline__ unsigned pk2(float lo, float hi) { return f2bf(lo) | (f2bf(hi) << 16); }
__device__ __forceinline__ float bflo(unsigned u) { return __builtin_bit_cast(float, u << 16); }
__device__ __forceinline__ float bfhi(unsigned u) { return __builtin_bit_cast(float, u & 0xffff0000u); }
__device__ __forceinline__ float wave_sum(float v) {
#pragma unroll
    for (int o = 1; o < 64; o <<= 1) v += __shfl_xor(v, o);
    return v;
}
__device__ __forceinline__ float sum_x16_x32(float v) {
    float a = v, b = v;
    asm volatile("s_nop 1\n\tv_permlane16_swap_b32 %0, %1\n\ts_nop 1" : "+v"(a), "+v"(b));
    a = a + b; b = a;
    asm volatile("s_nop 1\n\tv_permlane32_swap_b32 %0, %1\n\ts_nop 1" : "+v"(a), "+v"(b));
    return a + b;
}
__device__ __forceinline__ float row_rstd(const float* ssq, int row) {
    const float* p = ssq + (size_t)row * 16;
    const f32x4 a = gld<f32x4>(p), b = gld<f32x4>(p + 4), c = gld<f32x4>(p + 8), d = gld<f32x4>(p + 12);
    const f32x4 s = (a + b) + (c + d);
    const float t = (s[0] + s[1]) + (s[2] + s[3]);
    return __builtin_amdgcn_rsqf(t * (1.f / 1024.f) + RMS_EPS);
}
__device__ __forceinline__ u32x4 pack8(const f32x4 a, const f32x4 b) {
    u32x4 w; w.x = cvt_pk_bf16(a[0], a[1]); w.y = cvt_pk_bf16(a[2], a[3]); w.z = cvt_pk_bf16(b[0], b[1]); w.w = cvt_pk_bf16(b[2], b[3]); return w;
}

struct EpiSwiglu {
    static constexpr bool PERM = true, PROBE2 = false, RSTD = true; static constexpr bool PEEL = true;
    bf16_t* O; const float* ssq;
    __device__ __forceinline__ float rstd_global(int row) const { return row_rstd(ssq, row); }
    __device__ __forceinline__ void operator()(const f32x4 (&acc)[2][2][4][2], const Unit& u, int wr, int wc, int fr, int fq, const LAS float* rt) const {
        const int row0 = u.pm * 256 + wr * 64 + fr;
        bf16_t* Ob = O + (size_t)(2 * u.pn + (wc >> 1)) * M * 64 + (wc & 1) * 32 + 8 * fq;
        float rsv[2][4];
#pragma unroll
        for (int ai = 0; ai < 2; ++ai)
#pragma unroll
            for (int m = 0; m < 4; ++m) rsv[ai][m] = rt ? rt[wr * 64 + fr + ai * 128 + m * 16] : row_rstd(ssq, row0 + ai * 128 + m * 16);
#pragma unroll
        for (int ai = 0; ai < 2; ++ai)
#pragma unroll
            for (int m = 0; m < 4; ++m) {
                const int row = row0 + ai * 128 + m * 16; const float rs = rsv[ai][m], nrs = -rs * LOG2E, irs2 = __builtin_amdgcn_rcpf(rs * rs);
                f32x4 o[2];
#pragma unroll
                for (int n = 0; n < 2; ++n) {
                    const f32x4 g = acc[ai][0][m][n], up = acc[ai][1][m][n];
#pragma unroll
                    for (int e = 0; e < 4; e += 2) {
                        typedef float f32x2 __attribute__((ext_vector_type(2)));
                        const f32x2 gg = (f32x2){g[e], g[e + 1]}, uu = (f32x2){up[e], up[e + 1]};
                        const f32x2 t = gg * nrs;
                        f32x2 ex; ex.x = __builtin_amdgcn_exp2f(t.x); ex.y = __builtin_amdgcn_exp2f(t.y);
                        const f32x2 d = ex * irs2 + irs2;
                        f32x2 r; r.x = __builtin_amdgcn_rcpf(d.x); r.y = __builtin_amdgcn_rcpf(d.y);
                        const f32x2 oo = (gg * uu) * r; o[n][e] = oo.x; o[n][e + 1] = oo.y; }
                }
                gst<u32x4>(Ob + (size_t)row * 64, pack8(o[0], o[1]));
            }
    }
};
struct EpiConvIn {
    static constexpr bool PERM = true, PROBE2 = false, RSTD = true; static constexpr bool PEEL = true;
    bf16_t* V; bf16_t* Bg; const float* ssq;
    __device__ __forceinline__ float rstd_global(int row) const { return row_rstd(ssq, row); }
    __device__ __forceinline__ void operator()(const f32x4 (&acc)[2][2][4][2], const Unit& u, int wr, int wc, int fr, int fq, const LAS float* rt) const {
        const int row0 = u.pm * 256 + wr * 64 + fr;
#pragma unroll
        for (int ai = 0; ai < 2; ++ai)
#pragma unroll
            for (int m = 0; m < 4; ++m) {
                const int row = row0 + ai * 128 + m * 16; const float rs = rt ? rt[wr * 64 + fr + ai * 128 + m * 16] : row_rstd(ssq, row);
                if (u.pn < 8) {
                    const float r2 = rs * rs;
                    const f32x4 o0 = acc[ai][0][m][0] * acc[ai][1][m][0] * r2, o1 = acc[ai][0][m][1] * acc[ai][1][m][1] * r2;
                    gst<u32x4>(V + (size_t)row * D + u.pn * 128 + wc * 32 + 8 * fq, pack8(o0, o1));
                } else {
#pragma unroll
                    for (int bj = 0; bj < 2; ++bj)
                        gst<u32x4>(Bg + (size_t)row * D + (u.pn - 8) * 256 + bj * 128 + wc * 32 + 8 * fq, pack8(acc[ai][bj][m][0] * rs, acc[ai][bj][m][1] * rs));
                }
            }
    }
};
struct EpiQKV {
    static constexpr bool PERM = true, PROBE2 = false, RSTD = true; static constexpr bool PEEL = true;
    bf16_t* O; const float* ssq; const float* qg; const float* kg; int rsh;
    __device__ __forceinline__ float rstd_global(int row) const { return row_rstd(ssq, row); }
    __device__ __forceinline__ void operator()(const f32x4 (&acc)[2][2][4][2], const Unit& u, int wr, int wc, int fr, int fq, const LAS float* rt) const {
        const int row0 = u.pm * 256 + wr * 64 + fr, kind = u.pn >> 2;
        f32x4 gv[2][2];
#pragma unroll
        for (int bj = 0; bj < 2; ++bj)
#pragma unroll
            for (int n = 0; n < 2; ++n) {
                if (kind < 2) { const float* gp = (kind == 0 ? qg : kg) + 32 * bj + 8 * fq + 4 * n; const float sc = kind == 0 ? 0.125f * LOG2E : 1.f; gv[bj][n] = gld<f32x4>(gp) * sc; }
                else gv[bj][n] = (f32x4){1.f, 1.f, 1.f, 1.f};
            }
#pragma unroll
        for (int ai = 0; ai < 2; ++ai)
#pragma unroll
            for (int m = 0; m < 4; ++m) {
                const int row = row0 + ai * 128 + m * 16; const float rs = rt ? rt[wr * 64 + fr + ai * 128 + m * 16] : row_rstd(ssq, row);
                f32x4 v[2][2]; float ss = 0.f;
#pragma unroll
                for (int bj = 0; bj < 2; ++bj)
#pragma unroll
                    for (int n = 0; n < 2; ++n) { v[bj][n] = acc[ai][bj][m][n] * rs; const f32x4 q = v[bj][n] * v[bj][n]; ss += (q[0] + q[1]) + (q[2] + q[3]); }
                ss = sum_x16_x32(ss);
                const float sc = kind < 2 ? __builtin_amdgcn_rsqf(ss * (1.f / 64.f) + RMS_EPS) : 1.f;
                const int tt = row & (SEQ - 1); const int prow = (row & ~(SEQ - 1)) + (tt & ((1 << rsh) - 1)) * (SEQ >> rsh) + (tt >> rsh);
#pragma unroll
                for (int bj = 0; bj < 2; ++bj)
                    gst<u32x4>(O + ((size_t)(kind * 16 + 4 * (u.pn & 3) + wc) * M + prow) * 64 + 32 * bj + 8 * fq, pack8(v[bj][0] * sc * gv[bj][0], v[bj][1] * sc * gv[bj][1]));
            }
    }
};
struct EpiResid {
    static constexpr bool PERM = true, PROBE2 = false, RSTD = false; static constexpr bool PEEL = false;
    float* out32; bf16_t* hb; float* ssq; float scale;
    __device__ __forceinline__ void operator()(const f32x4 (&acc)[2][2][4][2], const Unit& u, int wr, int wc, int fr, int fq) const {
        const int row0 = u.pm * 256 + wr * 64 + fr, col0 = u.pn * 256 + wc * 32 + 8 * fq;
        bf16_t* hbk = hb + (size_t)(u.pn * 4 + (wc >> 1)) * M * 64 + (wc & 1) * 32 + 8 * fq; constexpr size_t BJS = (size_t)2 * M * 64;
        const bf16_t* hrow = hbk + (size_t)row0 * 64;
#pragma unroll
        for (int ai = 0; ai < 2; ++ai) {
            u32x4 bq[4][2];
#pragma unroll
            for (int m = 0; m < 4; ++m)
#pragma unroll
                for (int bj = 0; bj < 2; ++bj) bq[m][bj] = gld<u32x4>(hrow + bj * BJS + (size_t)(ai * 128 + m * 16) * 64);
            asm volatile("" ::: "memory");
#pragma unroll
            for (int m = 0; m < 4; ++m) {
                const int row = row0 + ai * 128 + m * 16; const size_t off = (size_t)row * D + col0; float ss = 0.f;
#pragma unroll
                for (int bj = 0; bj < 2; ++bj) {
                    const u32x4 q = bq[m][bj];
                    const f32x4 b0 = (f32x4){bflo(q.x), bfhi(q.x), bflo(q.y), bfhi(q.y)}, b1 = (f32x4){bflo(q.z), bfhi(q.z), bflo(q.w), bfhi(q.w)};
                    const f32x4 h0 = b0 + acc[ai][bj][m][0] * scale, h1 = b1 + acc[ai][bj][m][1] * scale;
                    if (out32) { gst<f32x4>(out32 + off + bj * 128, h0); gst<f32x4>(out32 + off + bj * 128 + 4, h1); }
                    else {
                        const f32x4 q0 = h0 * h0, q1 = h1 * h1; ss += ((q0[0] + q0[1]) + (q0[2] + q0[3])) + ((q1[0] + q1[1]) + (q1[2] + q1[3]));
                        gst<u32x4>((bf16_t*)hrow + bj * BJS + (size_t)(ai * 128 + m * 16) * 64, pack8(h0, h1));
                    }
                }
                if (!out32) { ss = sum_x16_x32(ss); if (fq == 0) gst<float>(ssq + (size_t)row * 16 + u.pn * 4 + wc, ss); }
            }
            asm volatile("" ::: "memory");
        }
    }
};

__device__ __forceinline__ void transpose_item(const float* W, int K, int N, int n0src, const float* gk, bf16_t* WT, int drow0, LAS float* scr, int kb, int lane) {
    const int k0 = 64 * kb;
    float tv[32];
#pragma unroll
    for (int i = 0; i < 32; ++i) { const int kk = 2 * i + (lane >> 5); tv[i] = W[(size_t)(k0 + kk) * N + n0src + (lane & 31)]; }
    if (gk) {
#pragma unroll
        for (int i = 0; i < 32; ++i) tv[i] *= gk[k0 + 2 * i + (lane >> 5)];
    }
#pragma unroll
    for (int i = 0; i < 32; ++i) scr[(2 * i + (lane >> 5)) * 33 + (lane & 31)] = tv[i];
    asm volatile("s_waitcnt lgkmcnt(0)" ::: "memory");
    const int c = lane & 7;
#pragma unroll
    for (int j = 0; j < 4; ++j) { const int n = (lane >> 3) + 8 * j; const LAS float* s = scr + (8 * c) * 33 + n;
        u32x4 o; o.x = pk2(s[0 * 33], s[1 * 33]); o.y = pk2(s[2 * 33], s[3 * 33]); o.z = pk2(s[4 * 33], s[5 * 33]); o.w = pk2(s[6 * 33], s[7 * 33]);
        gst<u32x4>(WT + (size_t)(drow0 + n) * K + k0 + 8 * c, o); }
    asm volatile("s_waitcnt lgkmcnt(0)" ::: "memory");
}

struct Args {
    const float* in[16]; float* out; unsigned char* ws; int step_lo, step_hi;
};

__device__ __forceinline__ int t5_bucket(int dist) {
    if (dist < 16) return dist;
    const float nf = (float)dist;
    int large = 16 + (int)(logf(nf / 16.f) / 4.852030263919617f * 16.f);
    return large < 31 ? large : 31;
}

__device__ __forceinline__ void prologue(const Args& a, LAS unsigned char* lds) {
    int tid = threadIdx.x; asm volatile("" : "+v"(tid));
    const int lane = tid & 63, wave = __builtin_amdgcn_readfirstlane(tid >> 6);
    LAS float* scr = (LAS float*)(lds + wave * 16384);
    const int gw = blockIdx.x * NWAVES + wave, NGW = gridDim.x * NWAVES;
    unsigned char* ws = a.ws;
    constexpr int I_FI = 16 * 176, I_FO = 44 * 32, I_CI = 16 * 96, I_CO = 16 * 32, I_QKV = 16 * 288, I_AO = 16 * 32;
    constexpr int NITEMS = 4 * I_FI + 4 * I_FO + I_CI + I_CO + I_QKV + I_AO;
    for (int it = gw; it < NITEMS; it += NGW) {
        int r = it;
        if (r < 4 * I_FI) {
            const int s = r / I_FI; r -= s * I_FI; const int kb = r / 176, rb = r % 176, layer = s >> 1, second = s & 1;
            const float* W = a.in[second ? 14 : 2] + (size_t)layer * D * 2 * FF; const float* gk = a.in[second ? 13 : 1] + layer * D;
            const int pn = rb >> 3, half = (rb >> 2) & 1, j32 = rb & 3;
            transpose_item(W, D, 2 * FF, half * FF + pn * 128 + j32 * 32, gk, (bf16_t*)(ws + WS_WFI + s * WFI_STRIDE), rb * 32, scr, kb, lane); continue; }
        r -= 4 * I_FI;
        if (r < 4 * I_FO) {
            const int s = r / I_FO; r -= s * I_FO; const int kb = r / 32, rb = r % 32, layer = s >> 1, second = s & 1;
            const float* W = a.in[second ? 15 : 3] + (size_t)layer * FF * D;
            transpose_item(W, FF, D, rb * 32, nullptr, (bf16_t*)(ws + WS_WFO + s * WFO_STRIDE), rb * 32, scr, kb, lane); continue; }
        r -= 4 * I_FO;
        if (r < I_CI) {
            const int kb = r / 96, rb = r % 96; int src;
            if (rb < 64) { const int pn = rb >> 3, half = (rb >> 2) & 1, j32 = rb & 3; src = 1024 + half * 1024 + pn * 128 + j32 * 32; } else src = (rb - 64) * 32;
            transpose_item(a.in[5], D, 3 * D, src, a.in[4], (bf16_t*)(ws + WS_WCI), rb * 32, scr, kb, lane); continue; }
        r -= I_CI;
        if (r < I_CO) { const int kb = r / 32, rb = r % 32; transpose_item(a.in[7], D, D, rb * 32, nullptr, (bf16_t*)(ws + WS_WCO), rb * 32, scr, kb, lane); continue; }
        r -= I_CO;
        if (r < I_QKV) {
            const int kb = r / 288, rb = r % 288, g = rb / 96, rbl = rb % 96, pn = rbl >> 3, bj = (rbl >> 2) & 1, wc = rbl & 3;
            transpose_item(a.in[8], D, 9 * D, g * 3072 + pn * 256 + 64 * wc + 32 * bj, a.in[4] + D, (bf16_t*)(ws + WS_WQKV), rb * 32, scr, kb, lane); continue; }
        r -= I_QKV;
        { const int kb = r / 32, rb = r % 32; transpose_item(a.in[11], D, D, rb * 32, nullptr, (bf16_t*)(ws + WS_WAO), rb * 32, scr, kb, lane); }
    }
    bf16_t* HB = (bf16_t*)(ws + WS_HB); float* ssq0 = (float*)(ws + WS_SSQ);
    for (int m0 = 2 * gw; m0 < M; m0 += 2 * NGW) {
        f32x4 v[2][4];
#pragma unroll
        for (int q = 0; q < 2; ++q) { const f32x4* xr = (const f32x4*)(a.in[0] + (size_t)(m0 + q) * D) + lane;
#pragma unroll
            for (int j = 0; j < 4; ++j) v[q][j] = xr[64 * j]; }
#pragma unroll
        for (int q = 0; q < 2; ++q) {
            float s = 0.f;
#pragma unroll
            for (int j = 0; j < 4; ++j) s += (v[q][j].x * v[q][j].x + v[q][j].y * v[q][j].y) + (v[q][j].z * v[q][j].z + v[q][j].w * v[q][j].w);
            s = wave_sum(s);
#pragma unroll
            for (int j = 0; j < 4; ++j) {
                unsigned long long* o8 = (unsigned long long*)(HB + ((size_t)((lane >> 4) + 4 * j) * M + (m0 + q)) * 64 + ((4 * lane) & 63));
                *o8 = (unsigned long long)pk2(v[q][j].x, v[q][j].y) | ((unsigned long long)pk2(v[q][j].z, v[q][j].w) << 32); }
            if (lane < 16) ssq0[(size_t)(m0 + q) * 16 + lane] = lane == 0 ? s : 0.f;
        }
    }
    float* BT = (float*)(ws + WS_BIAS);
    for (int i = blockIdx.x * NTHREADS + tid; i < 3 * 16 * 192; i += gridDim.x * NTHREADS) {
        const int g = i / (16 * 192), h = (i / 192) % 16, idx = i % 192, step = idx - 32;
        float v = -INFINITY;
        if (step >= 0 && step <= 128) { const int dist = step << (2 * g); v = a.in[12][t5_bucket(dist) * 48 + g * 16 + h] * LOG2E; }
        BT[i] = v;
    }
}

__device__ __forceinline__ void conv_taps(const u32x4 v0, const u32x4 v1, const u32x4 v2, const u32x4 bb, const f32x4 (&w)[3][2], bf16_t* yp) {
    f32x4 oa, ob;
#pragma unroll
    for (int e = 0; e < 4; ++e) {
        const unsigned a0 = v0[e], a1 = v1[e], a2 = v2[e], b = bb[e];
        const float wl0 = e < 2 ? w[0][0][2 * e] : w[0][1][2 * e - 4], wh0 = e < 2 ? w[0][0][2 * e + 1] : w[0][1][2 * e - 3];
        const float wl1 = e < 2 ? w[1][0][2 * e] : w[1][1][2 * e - 4], wh1 = e < 2 ? w[1][0][2 * e + 1] : w[1][1][2 * e - 3];
        const float wl2 = e < 2 ? w[2][0][2 * e] : w[2][1][2 * e - 4], wh2 = e < 2 ? w[2][0][2 * e + 1] : w[2][1][2 * e - 3];
        const float lo = bflo(b) * (wl0 * bflo(a0) + wl1 * bflo(a1) + wl2 * bflo(a2));
        const float hi = bfhi(b) * (wh0 * bfhi(a0) + wh1 * bfhi(a1) + wh2 * bfhi(a2));
        if (e < 2) { oa[2 * e] = lo; oa[2 * e + 1] = hi; } else { ob[2 * e - 4] = lo; ob[2 * e - 3] = hi; }
    }
    gst<u32x4>(yp, pack8(oa, ob));
}
__device__ __forceinline__ void conv_ew(const bf16_t* __restrict__ V, const bf16_t* __restrict__ Bg, bf16_t* __restrict__ Y, const float* __restrict__ cw) {
    const int nth = gridDim.x * NTHREADS; int tid = threadIdx.x; asm volatile("" : "+v"(tid));
    constexpr int RUN = 32;
    for (int i = blockIdx.x * NTHREADS + tid; i < (M / RUN) * 128; i += nth) {
        const int c8 = (i & 127) * 8, r0 = (i >> 7) * RUN, t0 = r0 & (SEQ - 1);
        f32x4 w[3][2];
#pragma unroll
        for (int l = 0; l < 3; ++l) { w[l][0] = gld<f32x4>(cw + l * D + c8); w[l][1] = gld<f32x4>(cw + l * D + c8 + 4); }
        const size_t off0 = (size_t)r0 * D + c8;
        const u32x4 z = (u32x4){0u, 0u, 0u, 0u};
        u32x4 vm1 = t0 >= 1 ? gld<u32x4>(V + off0 - D) : z, vm2 = t0 >= 2 ? gld<u32x4>(V + off0 - 2 * D) : z;
        for (int r = 0; r < RUN; r += 4) {
            u32x4 v[4], b[4];
#pragma unroll
            for (int j = 0; j < 4; ++j) { v[j] = gld<u32x4>(V + off0 + (size_t)(r + j) * D); b[j] = gld<u32x4>(Bg + off0 + (size_t)(r + j) * D); }
            conv_taps(v[0], vm1, vm2, b[0], w, Y + off0 + (size_t)(r + 0) * D);
            conv_taps(v[1], v[0], vm1, b[1], w, Y + off0 + (size_t)(r + 1) * D);
            conv_taps(v[2], v[1], v[0], b[2], w, Y + off0 + (size_t)(r + 2) * D);
            conv_taps(v[3], v[2], v[1], b[3], w, Y + off0 + (size_t)(r + 3) * D);
            vm1 = v[3]; vm2 = v[2];
        }
    }
}

__device__ __forceinline__ int crow(int r, int hi) { return (r & 3) + 8 * (r >> 2) + 4 * hi; }
__device__ __forceinline__ v4i16_t vtr(const LAS unsigned char* p) { return __builtin_amdgcn_ds_read_tr16_b64_v4i16((LAS v4i16_t*)p); }

typedef unsigned u32x2 __attribute__((ext_vector_type(2)));
__device__ __forceinline__ void attn_load(const bf16_t* qkv, const float* biasG, const int rsh, const int unit, const int tid, const int w, const int r32, const int hi,
                                          u32x4 (&kr)[6], u32x4 (&vr)[6], bf16x8 (&qn)[4], float& bn) {
    const int per = 32 >> rsh, RL = per < 8 ? per : 8;
    const int idx32 = unit & 31, np = idx32 & (per - 1), s = idx32 >> (5 - rsh), h = (unit >> 5) & 15, b = unit >> 9, j = np & (RL - 1);
    const size_t rowb = (size_t)b * SEQ;
#pragma unroll
    for (int it = 0; it < 6; ++it) {
        const int idx = tid + 512 * it, kl = idx >> 3, ch = idx & 7;
        const int mpos = j == 0 ? 256 * np - 128 + kl : 256 * np + kl;
        const bool want = j == 0 || it < 4;
        if (want) {
            if (mpos >= 0) { const bf16_t* p = qkv + ((size_t)(16 + h) * M + rowb + (size_t)s * (SEQ >> rsh) + mpos) * 64 + ch * 8; kr[it] = gld<u32x4>(p); vr[it] = gld<u32x4>(p + (size_t)16 * M * 64); }
            else { kr[it] = (u32x4){0u, 0u, 0u, 0u}; vr[it] = (u32x4){0u, 0u, 0u, 0u}; }
        }
    }
    { const int mq = 256 * np + 32 * w + r32; const bf16_t* p = qkv + ((size_t)h * M + rowb + (size_t)s * (SEQ >> rsh) + mq) * 64 + hi * 8;
#pragma unroll
      for (int d0 = 0; d0 < 4; ++d0) qn[d0] = gld<bf16x8>(p + 16 * d0); }
    bn = tid < 192 ? gld<float>(biasG + h * 192 + tid) : 0.f;
}

__device__ __forceinline__ void attn_phase(LAS unsigned char* lds, const bf16_t* qkv, bf16_t* obuf, float* lse, const float* biasG, const int gi, const int rsh, const int G) {
    int tid = threadIdx.x; asm volatile("" : "+v"(tid));
    const int lane = tid & 63, r32 = lane & 31, hi = lane >> 5, w = __builtin_amdgcn_readfirstlane(tid >> 6);
    const int per = 32 >> rsh, RL = per < 8 ? per : 8;
    int unit = (int)blockIdx.x * RL; if (unit >= 2048) return;
    u32x4 kr[6], vr[6]; bf16x8 qn[4]; float bn;
    attn_load(qkv, biasG, rsh, unit, tid, w, r32, hi, kr, vr, qn, bn);
    for (;;) {
        const int idx32 = unit & 31, np = idx32 & (per - 1), s = idx32 >> (5 - rsh), h = (unit >> 5) & 15, b = unit >> 9, j = np & (RL - 1);
        const size_t rowb = (size_t)b * SEQ;
        if (tid < 192) ((LAS float*)(lds + A_BT))[tid] = bn;
        const int wbase = j == 0 ? 0 : ((2 * j + 1) % 3) * 128;
#pragma unroll
        for (int it = 0; it < 6; ++it) {
            const int idx = tid + 512 * it, kl = idx >> 3, ch = idx & 7;
            if (j == 0 || it < 4) {
                int row = wbase + kl; row = row >= 384 ? row - 384 : row;
                *(LAS u32x4*)(lds + A_K0 + ch * KCS + row * 16) = kr[it];
                *(LAS u32x4*)(lds + A_V0 + (ch >> 2) * VHS + row * 64 + (ch & 3) * 16) = vr[it];
            }
        }
        bf16x8 qr[4];
#pragma unroll
        for (int d0 = 0; d0 < 4; ++d0) qr[d0] = qn[d0];
        asm volatile("s_waitcnt lgkmcnt(0)\n\ts_barrier" ::: "memory");
        const int nu = ((unit + 1) & (RL - 1)) ? unit + 1 : unit + 1 + (G - 1) * RL; const bool has_next = nu < 2048;
        const int mq = 256 * np + 32 * w + r32; const size_t growq = rowb + ((size_t)mq << rsh) + s;
        float lp = 0.f; if (gi > 0) lp = gld<float>(lse + growq * 16 + h);
        if (has_next) attn_load(qkv, biasG, rsh, nu, tid, w, r32, hi, kr, vr, qn, bn);
        const int c0 = ((2 * j) % 3) * 4 + w;
        int sc[5];
#pragma unroll
        for (int cc = 0; cc < 5; ++cc) { const int t = c0 + cc; sc[cc] = t >= 12 ? t - 12 : t; }
        f32x16 p[5];
        const LAS float* bt = (const LAS float*)(lds + A_BT);
        const LAS unsigned char* kbase = lds + A_K0 + hi * KCS + r32 * 16;
#pragma unroll
        for (int c2 = 0; c2 < 5; c2 += 2) {
            bf16x8 ka[4], kb[4];
#pragma unroll
            for (int d0 = 0; d0 < 4; ++d0) { ka[d0] = *(const LAS bf16x8*)(kbase + 2 * d0 * KCS + sc[c2] * 512); if (c2 + 1 < 5) kb[d0] = *(const LAS bf16x8*)(kbase + 2 * d0 * KCS + sc[c2 + 1 < 5 ? c2 + 1 : c2] * 512); }
#pragma unroll
            for (int q = 0; q < 2; ++q) { const int cc = c2 + q; if (cc < 5) { const bool dead = (np == 0) && (w + cc < 4);
                const LAS float* bq_ = dead ? bt + 27 - (160 + r32 - 32 * cc - 4 * hi) : bt;
#pragma unroll
                for (int r = 0; r < 16; ++r) p[cc][r] = bq_[160 + r32 - 32 * cc - crow(r, hi)]; } }
            __builtin_amdgcn_sched_barrier(0);
#pragma unroll
            for (int d0 = 0; d0 < 4; ++d0) {
                p[c2] = __builtin_amdgcn_mfma_f32_32x32x16_bf16(ka[d0], qr[d0], p[c2], 0, 0, 0);
                if (c2 + 1 < 5) p[c2 + 1 < 5 ? c2 + 1 : c2] = __builtin_amdgcn_mfma_f32_32x32x16_bf16(kb[d0], qr[d0], p[c2 + 1 < 5 ? c2 + 1 : c2], 0, 0, 0);
            }
            __builtin_amdgcn_sched_barrier(0);
        }
        float mx = p[0][0];
#pragma unroll
        for (int cc = 0; cc < 5; ++cc)
#pragma unroll
            for (int r = 0; r < 16; ++r) mx = fmaxf(mx, p[cc][r]);
        mx = fmaxf(mx, __shfl_xor(mx, 32));
        typedef float f32x2 __attribute__((ext_vector_type(2)));
        f32x2 l2 = (f32x2){0.f, 0.f};
#define ATT_EXP8(cc_, r0_) do { _Pragma("unroll") for (int r = (r0_); r < (r0_) + 8; r += 2) { \
                const f32x2 d_ = (f32x2){p[cc_][r], p[cc_][r + 1]} - mx; f32x2 e_; e_.x = __builtin_amdgcn_exp2f(d_.x); e_.y = __builtin_amdgcn_exp2f(d_.y); \
                p[cc_][r] = e_.x; p[cc_][r + 1] = e_.y; l2 += e_; } } while (0)
        ATT_EXP8(0, 0); ATT_EXP8(0, 8);
        bf16_t* og = obuf + ((size_t)h * M + growq) * 64 + 4 * hi;
        u32x2 prev[2][4];
        f32x16 o[2];
#pragma unroll
        for (int r = 0; r < 16; ++r) { o[0][r] = 0.f; o[1][r] = 0.f; }
        const LAS unsigned char* vb = lds + A_V0 + ((lane >> 4) & 1) * 32 + (lane & 3) * 8 + (4 * hi + ((lane & 15) >> 2)) * 64;
#pragma unroll
        for (int cc = 0; cc < 5; ++cc)
#pragma unroll
            for (int gk = 0; gk < 2; ++gk) {
                if (cc == 3 && gk == 0 && gi > 0) {
#pragma unroll
                    for (int d0 = 0; d0 < 2; ++d0)
#pragma unroll
                        for (int rq = 0; rq < 4; ++rq) prev[d0][rq] = gld<u32x2>(og + 32 * d0 + 8 * rq);
                }
                if (cc + 1 < 5) ATT_EXP8(cc + 1 < 5 ? cc + 1 : cc, 8 * gk);
                u32x4 pw; pw.x = cvt_pk_bf16(p[cc][8 * gk + 0], p[cc][8 * gk + 1]); pw.y = cvt_pk_bf16(p[cc][8 * gk + 2], p[cc][8 * gk + 3]);
                pw.z = cvt_pk_bf16(p[cc][8 * gk + 4], p[cc][8 * gk + 5]); pw.w = cvt_pk_bf16(p[cc][8 * gk + 6], p[cc][8 * gk + 7]);
                const bf16x8 pa = __builtin_bit_cast(bf16x8, pw);
                const LAS unsigned char* vrow = vb + sc[cc] * 2048 + gk * 1024;
#pragma unroll
                for (int d0 = 0; d0 < 2; ++d0) {
                    const v4i16_t lo = vtr(vrow + d0 * VHS), hh = vtr(vrow + d0 * VHS + 512);
                    const bf16x8 vf = (bf16x8){lo[0], lo[1], lo[2], lo[3], hh[0], hh[1], hh[2], hh[3]};
                    o[d0] = __builtin_amdgcn_mfma_f32_32x32x16_bf16(vf, pa, o[d0], 0, 0, 0);
                }
            }
#undef ATT_EXP8
        float l = l2.x + l2.y;
        l += __shfl_xor(l, 32);
        const float lse_new = mx + __builtin_amdgcn_logf(l);
        float ca = 0.f, cb = 1.0f / l, lse_out = lse_new;
        if (gi > 0) {
            const float mm = fmaxf(lp, lse_new);
            const float wa = __builtin_amdgcn_exp2f(lp - mm), wb = __builtin_amdgcn_exp2f(lse_new - mm), tot = wa + wb, it = 1.0f / tot;
            ca = wa * it; cb = wb * it / l; lse_out = mm + __builtin_amdgcn_logf(tot);
        }
        if (gi < 2 && hi == 0) gst<float>(lse + growq * 16 + h, lse_out);
#pragma unroll
        for (int d0 = 0; d0 < 2; ++d0)
#pragma unroll
            for (int rq = 0; rq < 4; ++rq) {
                float v0 = o[d0][4 * rq] * cb, v1 = o[d0][4 * rq + 1] * cb, v2 = o[d0][4 * rq + 2] * cb, v3 = o[d0][4 * rq + 3] * cb;
                if (gi > 0) { const u32x2 pv = prev[d0][rq]; v0 += ca * bflo(pv.x); v1 += ca * bfhi(pv.x); v2 += ca * bflo(pv.y); v3 += ca * bfhi(pv.y); }
                u32x2 ov; ov.x = cvt_pk_bf16(v0, v1); ov.y = cvt_pk_bf16(v2, v3);
                gst<u32x2>(og + 32 * d0 + 8 * rq, ov);
            }
        asm volatile("s_waitcnt lgkmcnt(0)\n\ts_barrier" ::: "memory");
        if (!has_next) break;
        unit = nu;
    }
}

#define XB_TMO      128
#define XB_XCNT(j)  (256  + 64 * (j))
#define XB_XSUB(j)  (1280 + 64 * (j))
#define XB_XGEN(j)  (2304 + 64 * (j))
#define XB_TOP      3328
#define XB_TOPGEN   3392
#define XCD_BAR_WORDS 3456
#define XB_SPIN_CAP (1u << 18)
__device__ __forceinline__ unsigned xb_ld(unsigned* p)              { return __hip_atomic_load(p, __ATOMIC_RELAXED, __HIP_MEMORY_SCOPE_AGENT); }
__device__ __forceinline__ unsigned xb_add(unsigned* p, unsigned v) { return __hip_atomic_fetch_add(p, v, __ATOMIC_RELAXED, __HIP_MEMORY_SCOPE_AGENT); }
__device__ __forceinline__ unsigned xb_xcc_id() { return (unsigned)__builtin_amdgcn_s_getreg((3 << 11) | 20) & 0xFu; }
#define XB_SPIN(cond, bar) do { unsigned _sp = 0; while (cond) { __builtin_amdgcn_s_sleep(1); \
    if ((++_sp & 255u) == 0u) { if (xb_ld(&(bar)[XB_TMO])) break; if (_sp > XB_SPIN_CAP) { atomicAdd(&(bar)[XB_TMO], 1u); break; } } } } while (0)
struct XcdBarrier { unsigned* bar; unsigned x; volatile LAS unsigned* st; };
__device__ __forceinline__ XcdBarrier xcd_barrier_post(unsigned* bar, volatile LAS unsigned* st) {
    XcdBarrier b; b.bar = bar; b.x = xb_xcc_id(); b.st = st;
    if (threadIdx.x == 0) (void)xb_add(&bar[XB_XCNT(b.x)], 1u);
    return b;
}
__device__ __forceinline__ void xcd_barrier_complete(unsigned* bar, unsigned x, unsigned& nloc, unsigned& nx) {
    const unsigned G = gridDim.x * gridDim.y * gridDim.z;
    unsigned sum, cnt, mine, sp = 0u;
    for (;;) {
        sum = 0u; cnt = 0u; mine = 0u;
#pragma unroll
        for (unsigned j = 0; j < 16; ++j) { const unsigned c = xb_ld(&bar[XB_XCNT(j)]); sum += c; cnt += (c > 0u) ? 1u : 0u; mine = (j == x) ? c : mine; }
        if (sum == G) break;
        __builtin_amdgcn_s_sleep(1);
        if ((++sp & 255u) == 0u) { if (xb_ld(&bar[XB_TMO])) break; if (sp > XB_SPIN_CAP) { atomicAdd(&bar[XB_TMO], 1u); break; } }
    }
    nloc = mine > 0u ? mine : 1u; nx = cnt > 0u ? cnt : 1u;
}
__device__ __forceinline__ void xcd_barrier(const XcdBarrier& b) {
    asm volatile("s_waitcnt vmcnt(0)" ::: "memory");
    __syncthreads();
    if (threadIdx.x == 0) {
        unsigned* bar = b.bar;
        __builtin_amdgcn_s_waitcnt(0);
        unsigned nloc = b.st[0], nx = b.st[1];
        if (nloc == 0u) { xcd_barrier_complete(bar, b.x, nloc, nx); b.st[0] = nloc; b.st[1] = nx; }
        const unsigned old = xb_add(&bar[XB_XSUB(b.x)], 1u);
        const unsigned gen = old / nloc;
        if (old + 1u == (gen + 1u) * nloc) {
            __builtin_amdgcn_fence(__ATOMIC_RELEASE, "agent");
            asm volatile("s_waitcnt vmcnt(0)" ::: "memory");
            const unsigned og = xb_add(&bar[XB_TOP], 1u);
            const unsigned tg = og / nx;
            if (og + 1u == (tg + 1u) * nx) xb_add(&bar[XB_TOPGEN], 1u);
            else XB_SPIN(xb_ld(&bar[XB_TOPGEN]) == tg, bar);
            __builtin_amdgcn_fence(__ATOMIC_ACQUIRE, "agent");
            xb_add(&bar[XB_XGEN(b.x)], 1u);
            asm volatile("s_waitcnt vmcnt(0)" ::: "memory");
        } else {
            XB_SPIN(xb_ld(&bar[XB_XGEN(b.x)]) == gen, bar);
            __builtin_amdgcn_fence(__ATOMIC_ACQUIRE, "agent");
            asm volatile("s_waitcnt vmcnt(0)" ::: "memory");
        }
    }
    __syncthreads();
}

__global__ void __launch_bounds__(NTHREADS, 2) fwd_megakernel(Args a) {
    extern __shared__ __attribute__((aligned(16))) unsigned char lds_raw[];
    LAS unsigned char* lds = (LAS unsigned char*)lds_raw;
    const int G = gridDim.x;
    volatile LAS unsigned* MISC = (volatile LAS unsigned*)(lds + MISC_OFF);
    if (threadIdx.x < 16) MISC[threadIdx.x] = 0u;
    __syncthreads();
    XcdBarrier bar; bar.bar = (unsigned*)(a.ws + WS_CTL); bar.x = 0; bar.st = MISC;
    if (a.step_hi - a.step_lo > 1) bar = xcd_barrier_post((unsigned*)(a.ws + WS_CTL), MISC);
#define SSQ(i) ((float*)(ws + WS_SSQ + (size_t)(i) * SSQ_STRIDE))
#define WFI(s) ((const bf16_t*)(ws + WS_WFI + (size_t)(s) * WFI_STRIDE))
#define WFO(s) ((const bf16_t*)(ws + WS_WFO + (size_t)(s) * WFO_STRIDE))
    for (int step = a.step_lo; step < a.step_hi; ++step) {
        unsigned char* ws = a.ws; asm volatile("" : "+s"(ws));
        bf16_t* HB = (bf16_t*)(ws + WS_HB); bf16_t* OB = (bf16_t*)(ws + WS_OB); bf16_t* R1 = (bf16_t*)(ws + WS_R1);
        float* LSE = (float*)(ws + WS_LSE);
        bf16_t* CV = R1; bf16_t* CB = R1 + (size_t)M * D; bf16_t* CY = R1 + (size_t)2 * M * D;
        int kind = 0, p0 = 0;
        switch (step) {
            case 0: kind = 0; break;
            case 1: kind = 1; p0 = 0; break;
            case 2: kind = 2; p0 = 0; break;
            case 3: kind = 3; break;
            case 4: kind = 4; break;
            case 5: kind = 2; p0 = 4; break;
            case 6: kind = 1; p0 = 1; break;
            case 7: kind = 2; p0 = 1; break;
            case 8: kind = 1; p0 = 2; break;
            case 9: kind = 2; p0 = 2; break;
            case 10: kind = 5; p0 = 0; break;
            case 11: kind = 6; p0 = 0; break;
            case 12: kind = 5; p0 = 1; break;
            case 13: kind = 6; p0 = 1; break;
            case 14: kind = 5; p0 = 2; break;
            case 15: kind = 6; p0 = 2; break;
            case 16: kind = 2; p0 = 5; break;
            case 17: kind = 1; p0 = 3; break;
            default: kind = 2; p0 = 3; break;
        }
        const int nrep = (step == PROBE_STEP) ? PROBE_REP : 1;
        for (int rep = 0; rep < nrep; ++rep) {
        if (kind == 0) {
            prologue(a, lds);
        } else if (kind == 1) {
            const int si = p0 == 0 ? 0 : p0 == 1 ? 2 : p0 == 2 ? 3 : 5;
            pg8::Gemm g{HB, WFI(p0), M, 2 * FF, D, 128, (size_t)M * 128}; pg8::StaticOrder S; S.init(M, 2 * FF, G, (int)blockIdx.x);
            EpiSwiglu E{R1, SSQ(si)};
            pg8::gemm_phase<EpiSwiglu, pg8::StaticOrder, true, true>(lds, g, S, E);
        } else if (kind == 2) {
            pg8::Gemm g; EpiResid E;
            if (p0 < 4) {
                g = pg8::Gemm{R1, WFO(p0), M, D, FF, 128, (size_t)M * 128};
                const int so = p0 == 0 ? 1 : p0 == 1 ? 3 : 4;
                E = EpiResid{p0 == 3 ? a.out : nullptr, HB, SSQ(so), 0.5f};
            } else if (p0 == 4) {
                g = pg8::Gemm{CY, (const bf16_t*)(ws + WS_WCO), M, D, D, 2 * D, 128};
                E = EpiResid{nullptr, HB, SSQ(2), 1.0f};
            } else {
                g = pg8::Gemm{OB, (const bf16_t*)(ws + WS_WAO), M, D, D, 128, (size_t)M * 128};
                E = EpiResid{nullptr, HB, SSQ(5), 1.0f};
            }
            pg8::StaticOrder S; S.init(M, D, G, (int)blockIdx.x);
            pg8::gemm_phase<EpiResid, pg8::StaticOrder, true, true>(lds, g, S, E);
        } else if (kind == 3) {
            pg8::Gemm g{HB, (const bf16_t*)(ws + WS_WCI), M, 3 * D, D, 128, (size_t)M * 128}; pg8::StaticOrder S; S.init(M, 3 * D, G, (int)blockIdx.x);
            EpiConvIn E{CV, CB, SSQ(1)};
            pg8::gemm_phase<EpiConvIn, pg8::StaticOrder, true, true>(lds, g, S, E);
        } else if (kind == 4) {
            conv_ew(CV, CB, CY, a.in[6]);
        } else if (kind == 5) {
            pg8::Gemm g{HB, (const bf16_t*)(ws + WS_WQKV) + (size_t)p0 * NQKVG * D, M, NQKVG, D, 128, (size_t)M * 128}; pg8::StaticOrder S; S.init(M, NQKVG, G, (int)blockIdx.x);
            EpiQKV E{R1, SSQ(4), a.in[9] + p0 * 64, a.in[10] + p0 * 64, 2 * p0};
            pg8::gemm_phase<EpiQKV, pg8::StaticOrder, true, true>(lds, g, S, E);
        } else {
            const float* biasG = (const float*)(ws + WS_BIAS) + p0 * 16 * 192;
            attn_phase(lds, R1, OB, LSE, biasG, p0, 2 * p0, G);
        }
        }
        if (step + 1 < a.step_hi) { if (a.step_hi > 1000) cg::this_grid().sync(); else xcd_barrier(bar); }
    }
}

constexpr int NSTEPS = 19;

extern "C" void kernel_launch(void* const* d_in, const int* in_sizes, int n_in, void* d_out, int out_size, void* d_ws, size_t ws_size, hipStream_t stream) {
    static int grid = 0;
    if (grid == 0) {
        if (n_in != 16 || in_sizes[0] != M * D || out_size != M * D || ws_size < WS_END) {
            fprintf(stderr, "kernel_launch: unexpected shapes n_in %d in0 %d out %d ws %zu (need %zu)\n", n_in, n_in > 0 ? in_sizes[0] : -1, out_size, ws_size, (size_t)WS_END); grid = -1; return; }
        int dev = 0, cus = 0, per_cu = 0;
        hipGetDevice(&dev); hipDeviceGetAttribute(&cus, hipDeviceAttributeMultiprocessorCount, dev);
        if (hipFuncSetAttribute((const void*)fwd_megakernel, hipFuncAttributeMaxDynamicSharedMemorySize, LDS_BYTES) != hipSuccess) { fprintf(stderr, "kernel_launch: hipFuncSetAttribute failed\n"); grid = -1; return; }
        if (hipOccupancyMaxActiveBlocksPerMultiprocessor(&per_cu, (const void*)fwd_megakernel, NTHREADS, LDS_BYTES) != hipSuccess || per_cu < 1) { fprintf(stderr, "kernel_launch: occupancy query says %d\n", per_cu); per_cu = 1; }
        (void)hipGetLastError();
        grid = cus * 1;
        fprintf(stderr, "kernel_launch: cus %d per_cu %d grid %d\n", cus, per_cu, grid);
    }
    if (grid < 0) return;
    if (hipMemsetAsync((char*)d_ws + WS_CTL, 0, 16384, stream) != hipSuccess) { fprintf(stderr, "kernel_launch: memset failed\n"); return; }
    Args a{};
    for (int i = 0; i < 16; ++i) a.in[i] = (const float*)d_in[i];
    a.out = (float*)d_out; a.ws = (unsigned char*)d_ws;
#if MK_ONE_LAUNCH
    a.step_lo = 0; a.step_hi = NSTEPS;
    void* args[] = {&a};
    hipError_t e = hipLaunchCooperativeKernel((const void*)fwd_megakernel, dim3(grid), dim3(NTHREADS), args, LDS_BYTES, stream);
    if (e != hipSuccess) fprintf(stderr, "cooperative launch failed: %s (grid %d)\n", hipGetErrorString(e), grid);
#else
    for (int s = 0; s < NSTEPS; ++s) { a.step_lo = s; a.step_hi = s + 1; hipLaunchKernelGGL(fwd_megakernel, dim3(grid), dim3(NTHREADS), LDS_BYTES, stream, a); }
#endif
}
```

```cpp
#include <hip/hip_runtime.h>
#include <hip/hip_cooperative_groups.h>
#include <cstdio>
#include <cstdint>
namespace cg = cooperative_groups;

#ifndef MK_ONE_LAUNCH
#define MK_ONE_LAUNCH 1
#endif
#ifndef PROBE_STEP
#define PROBE_STEP (-1)
#endif
#ifndef PROBE_EPI2
#define PROBE_EPI2 0
#endif
#ifndef PROBE_REP
#define PROBE_REP 1
#endif

namespace pg8 {
#define PG8_LAS __attribute__((address_space(3)))
typedef unsigned short bf16_t;
typedef short bf16x8 __attribute__((ext_vector_type(8)));
typedef float f32x4 __attribute__((ext_vector_type(4)));
typedef unsigned u32x4 __attribute__((ext_vector_type(4)));
constexpr int BM = 256, BK = 64, HALF = 128, HTB = HALF * BK * 2, STAGE_BYTES = 8 * HTB, NXCD = 8, WGM = 8;

__host__ __device__ __forceinline__ int lds_byte(int r, int c) { const int st = (r >> 4) * 2 + (c >> 5), rr = r & 15, cc = c & 31, ob = rr * 64 + cc * 2; return st * 1024 + (ob ^ (((ob >> 9) & 1) << 5)); }
__host__ __device__ __forceinline__ void stage_rc(int b, int& R, int& C) { const int st = b / 1024, sb = b % 1024, swz = sb ^ (((sb >> 9) & 1) << 5); R = (st >> 1) * 16 + swz / 64; C = (st & 1) * 32 + (swz % 64) / 2; }
__host__ __device__ __forceinline__ int perm32(int rho) { const int n = rho >> 4, i = rho & 15; return 8 * (i >> 2) + 4 * n + (i & 3); }

struct Unit { int pm, pn; };
struct Gemm { const bf16_t* A; const bf16_t* Bt; int M, N, K; int lda_b; size_t kstepA; };

struct StaticOrder {
    int nM, nN, nwg, G, c;
    __host__ __device__ void init(int M, int N, int G_, int c_) { nM = M / BM; nN = N / BM; nwg = nM * nN; G = G_; c = c_; }
    __host__ __device__ bool next(int i, Unit& u) const {
        const long L = (long)i * G + c; if (L >= nwg) return false;
        int wgid = (int)L; { const int q = nwg / NXCD, r = nwg % NXCD, xcd = wgid % NXCD, off = wgid / NXCD; wgid = (xcd < r ? xcd * (q + 1) : r * (q + 1) + (xcd - r) * q) + off; }
        const int nig = WGM * nN, gid = wgid / nig, fm = gid * WGM, gsz = (nM - fm) < WGM ? (nM - fm) : WGM;
        u.pm = fm + ((wgid % nig) % gsz); u.pn = (wgid % nig) / gsz; return true;
    }
    __device__ __forceinline__ void a_ready(const Unit&) const {}
    __device__ __forceinline__ void done(const Unit&) const {}
};


struct PairOrder {
    int G, c;
    __host__ __device__ void init(int G_, int c_) { G = G_; c = c_; }
    __host__ __device__ bool next(int i, Unit& u) const {
        if (G != 256) { const long L = (long)i * G + c; if (L >= 512) return false; u.pm = (int)(L >> 2); u.pn = (int)(L & 3); return true; }
        if (i >= 2) return false;
        const int x = c & 7, j = c >> 3;
        u.pm = 32 * (x >> 1) + 16 * i + (j & 15); u.pn = 2 * (x & 1) + (j >> 4); return true;
    }
    __device__ __forceinline__ void a_ready(const Unit&) const {}
    __device__ __forceinline__ void done(const Unit&) const {}
};

__device__ __forceinline__ unsigned cvt_pk_bf16(float lo, float hi) { unsigned r; asm volatile("v_cvt_pk_bf16_f32 %0, %1, %2" : "=v"(r) : "v"(lo), "v"(hi)); return r; }

template <class Epi, class Sched, bool ALIGN_EPI = false, bool SP2 = false>
__device__ __forceinline__ void gemm_phase(PG8_LAS unsigned char* lds, const Gemm g, const Sched& S, const Epi& E) {
    int tid = threadIdx.x; asm volatile("" : "+v"(tid));
    const int wid = __builtin_amdgcn_readfirstlane(tid >> 6), lane = tid & 63, wr = wid >> 2, wc = wid & 3, fr0 = lane & 15, fq0 = lane >> 4;
    const int K = g.K, nt = K / BK;
    unsigned voffA[2], voffB[2];
#pragma unroll
    for (int i = 0; i < 2; ++i) { int R, C; stage_rc(tid * 16 + i * 8192, R, C); const int Rb = Epi::PERM ? ((R & ~31) + perm32(R & 31)) : R;
        voffA[i] = (unsigned)(R * g.lda_b + C * 2); voffB[i] = (unsigned)(Rb * K + C) * 2u; }
    const size_t kstepB = (size_t)(BK * 2), hstepB = (size_t)HALF * K * 2, tstepB = 2 * hstepB;
    const size_t kstepA = g.kstepA, hstepA = (size_t)HALF * g.lda_b, tstepA = 2 * hstepA;
    const unsigned ldsw = (unsigned)wid * 1024u;
    const int aoff = lds_byte(wr * 64 + fr0, fq0 * 8), boff = lds_byte(wc * 32 + fr0, fq0 * 8);
#define PG8_SA(b, h) (((b) * 2 + (h)) * HTB)
#define PG8_SB(b, h) ((4 + (b) * 2 + (h)) * HTB)
#define PG8_STAGE(bufoff, gbase, voff) do { _Pragma("unroll") for (int _i = 0; _i < 2; ++_i) \
        __builtin_amdgcn_global_load_lds((const unsigned*)((const char*)(gbase) + (voff)[_i]), (PG8_LAS unsigned*)(lds + (bufoff) + ldsw + _i * 8192), 16, 0, 0); } while (0)
#define PG8_LDA(dst, b, h) do { _Pragma("unroll") for (int m = 0; m < 4; ++m) _Pragma("unroll") for (int k = 0; k < 2; ++k) dst[m][k] = *(const PG8_LAS bf16x8*)(lds + PG8_SA(b, h) + aoff + m * 2048 + k * 1024); } while (0)
#define PG8_LDB(dst, b, h) do { _Pragma("unroll") for (int n = 0; n < 2; ++n) _Pragma("unroll") for (int k = 0; k < 2; ++k) dst[n][k] = *(const PG8_LAS bf16x8*)(lds + PG8_SB(b, h) + boff + n * 2048 + k * 1024); } while (0)
#define PG8_MMA(ai, bj, At, Bt) do { __builtin_amdgcn_s_setprio(1); _Pragma("unroll") for (int m = 0; m < 4; ++m) _Pragma("unroll") for (int n = 0; n < 2; ++n) _Pragma("unroll") for (int k = 0; k < 2; ++k) \
        acc[ai][bj][m][n] = __builtin_amdgcn_mfma_f32_16x16x32_bf16(Bt[n][k], At[m][k], acc[ai][bj][m][n], 0, 0, 0); __builtin_amdgcn_s_setprio(0); } while (0)
#define PG8_WAIT_V(n) asm volatile("s_waitcnt vmcnt(" #n ")" ::: "memory")
#define PG8_WAIT_L(n) asm volatile("s_waitcnt lgkmcnt(" #n ")" ::: "memory")
#define PG8_BAR __builtin_amdgcn_s_barrier()
#define PG8_SCHED __builtin_amdgcn_sched_barrier(0)
    Unit cur, nxt; int ui = 0;
    if (!S.next(0, cur)) return;
    int pmc0 = -1, pmc1 = -1, pmc2 = -1, pmc3 = -1;
    if constexpr (Epi::RSTD) {
        PG8_LAS float* rt = (PG8_LAS float*)(lds + STAGE_BYTES);
        Unit tu;
        for (int i = 0; S.next(i, tu); ++i) {
            const int p = tu.pm;
            if (p != pmc0 && p != pmc1 && p != pmc2 && p != pmc3) {
                int slot = -1;
                if (pmc0 < 0) { pmc0 = p; slot = 0; } else if (pmc1 < 0) { pmc1 = p; slot = 1; } else if (pmc2 < 0) { pmc2 = p; slot = 2; } else if (pmc3 < 0) { pmc3 = p; slot = 3; }
                if (slot >= 0 && tid < 256) rt[slot * 256 + tid] = E.rstd_global(p * 256 + tid);
            }
        }
    }
    f32x4 acc[2][2][4][2];
#pragma unroll
    for (int a = 0; a < 2; ++a)
#pragma unroll
        for (int b = 0; b < 2; ++b)
#pragma unroll
            for (int m = 0; m < 4; ++m)
#pragma unroll
                for (int n = 0; n < 2; ++n) acc[a][b][m][n] = (f32x4){0.f, 0.f, 0.f, 0.f};
    bf16x8 At[4][2], B0[2][2], B1[2][2];
    const char* cA = (const char*)g.A + (size_t)cur.pm * tstepA; const char* cB = (const char*)g.Bt + (size_t)cur.pn * tstepB;
    S.a_ready(cur);
    if constexpr (SP2) {
        PG8_STAGE(PG8_SB(0, 0), cB, voffB); PG8_STAGE(PG8_SB(0, 1), cB + hstepB, voffB); PG8_STAGE(PG8_SA(0, 0), cA, voffA); PG8_STAGE(PG8_SA(0, 1), cA + hstepA, voffA);
        if (wr == 1) PG8_BAR;
        PG8_WAIT_V(2); PG8_BAR;
        PG8_STAGE(PG8_SB(1, 0), cB + kstepB, voffB); PG8_STAGE(PG8_SA(1, 0), cA + kstepA, voffA); PG8_STAGE(PG8_SB(1, 1), cB + hstepB + kstepB, voffB);
        PG8_WAIT_V(6); PG8_BAR;
    } else {
        PG8_STAGE(PG8_SB(0, 0), cB, voffB); PG8_STAGE(PG8_SA(0, 0), cA, voffA); PG8_STAGE(PG8_SB(0, 1), cB + hstepB, voffB); PG8_STAGE(PG8_SA(0, 1), cA + hstepA, voffA);
        if (wr == 1) PG8_BAR;
        PG8_WAIT_V(4); PG8_BAR;
        PG8_STAGE(PG8_SB(1, 0), cB + kstepB, voffB); PG8_STAGE(PG8_SA(1, 0), cA + kstepA, voffA); PG8_STAGE(PG8_SB(1, 1), cB + hstepB + kstepB, voffB);
        PG8_WAIT_V(6); PG8_BAR;
    }
    for (;;) {
        const bool has_next = S.next(ui + 1, nxt);
        const char* nA = has_next ? (const char*)g.A + (size_t)nxt.pm * tstepA : cA; const char* nB = has_next ? (const char*)g.Bt + (size_t)nxt.pn * tstepB : cB;
#define PG8_ITER(W0) do { \
            PG8_LDB(B0, 0, 0); PG8_LDB(B1, 0, 1); PG8_SCHED; PG8_LDA(At, 0, 0); PG8_STAGE(PG8_SA(1, 1), a1 + hstepA, voffA); \
            asm volatile("s_waitcnt vmcnt(%0)" :: "n"(W0) : "memory"); PG8_WAIT_L(0); PG8_BAR; PG8_MMA(0, 0, At, B0); PG8_MMA(0, 1, At, B1); PG8_BAR; PG8_SCHED; \
            PG8_LDA(At, 0, 1); PG8_STAGE(PG8_SB(0, 0), b2, voffB); PG8_STAGE(PG8_SB(0, 1), b2 + hstepB, voffB); PG8_STAGE(PG8_SA(0, 0), a2, voffA); \
            asm volatile("s_waitcnt vmcnt(%0)" :: "n"(W0) : "memory"); PG8_WAIT_L(0); PG8_BAR; PG8_MMA(1, 0, At, B0); PG8_MMA(1, 1, At, B1); PG8_BAR; PG8_SCHED; \
            PG8_LDB(B0, 1, 0); PG8_LDB(B1, 1, 1); PG8_SCHED; PG8_LDA(At, 1, 0); PG8_STAGE(PG8_SA(0, 1), a2 + hstepA, voffA); \
            PG8_WAIT_V(8); PG8_WAIT_L(0); PG8_BAR; PG8_MMA(0, 0, At, B0); PG8_MMA(0, 1, At, B1); PG8_BAR; PG8_SCHED; \
            PG8_LDA(At, 1, 1); PG8_STAGE(PG8_SB(1, 0), b3, voffB); PG8_STAGE(PG8_SB(1, 1), b3 + hstepB, voffB); PG8_STAGE(PG8_SA(1, 0), a3, voffA); \
            PG8_WAIT_V(8); PG8_WAIT_L(0); PG8_BAR; PG8_MMA(1, 0, At, B0); PG8_MMA(1, 1, At, B1); PG8_BAR; PG8_SCHED; } while (0)
        if constexpr (Epi::PEEL) {
            const char* a1 = cA + kstepA; const char* a2 = cA + 2 * kstepA; const char* b2 = cB + 2 * kstepB; const char* a3 = a2 + kstepA; const char* b3 = b2 + kstepB;
            PG8_ITER(8);
        }
        for (int t = (Epi::PEEL ? 2 : 0); t < nt; t += 2) {
            const bool last = (t == nt - 2);
            const char* a1 = cA + (size_t)(t + 1) * kstepA;
            const char* a2 = last ? nA : cA + (size_t)(t + 2) * kstepA; const char* b2 = last ? nB : cB + (size_t)(t + 2) * kstepB;
            const char* a3 = a2 + kstepA; const char* b3 = b2 + kstepB;
            PG8_ITER(8);
        }
#undef PG8_ITER
        if constexpr (ALIGN_EPI) { if (wr == 0) PG8_BAR; }
        int tid2 = threadIdx.x; asm volatile("" : "+v"(tid2)); const int fr = tid2 & 15, fq = (tid2 & 63) >> 4;
        if constexpr (Epi::RSTD) {
            const int slot = cur.pm == pmc0 ? 0 : cur.pm == pmc1 ? 1 : cur.pm == pmc2 ? 2 : cur.pm == pmc3 ? 3 : -1;
            E(acc, cur, wr, wc, fr, fq, slot >= 0 ? (const PG8_LAS float*)(lds + STAGE_BYTES) + slot * 256 : (const PG8_LAS float*)nullptr);
        } else E(acc, cur, wr, wc, fr, fq);
#if PROBE_EPI2

#endif
        S.done(cur);
        if (!has_next) break;
#pragma unroll
        for (int a = 0; a < 2; ++a)
#pragma unroll
            for (int b = 0; b < 2; ++b)
#pragma unroll
                for (int m = 0; m < 4; ++m)
#pragma unroll
                    for (int n = 0; n < 2; ++n) acc[a][b][m][n] = (f32x4){0.f, 0.f, 0.f, 0.f};
        cur = nxt; cA = nA; cB = nB; ++ui;
        if constexpr (ALIGN_EPI) { if (wr == 1) PG8_BAR; }
    }
    PG8_WAIT_V(0);
    if constexpr (!ALIGN_EPI) { if (wr == 0) PG8_BAR; }
    PG8_BAR;
#undef PG8_SA
#undef PG8_SB
#undef PG8_STAGE
#undef PG8_LDA
#undef PG8_LDB
#undef PG8_MMA
#undef PG8_WAIT_V
#undef PG8_WAIT_L
#undef PG8_BAR
#undef PG8_SCHED
}
}

using pg8::bf16_t; using pg8::bf16x8; using pg8::f32x4; using pg8::u32x4; using pg8::Unit; using pg8::cvt_pk_bf16;
#define LAS __attribute__((address_space(3)))
#define GAS __attribute__((address_space(1)))
template <class T> __device__ __forceinline__ T gld(const void* p) { return *(const GAS T*)p; }
template <class T> __device__ __forceinline__ void gst(void* p, const T v) { *(GAS T*)p = v; }
typedef float f32x16 __attribute__((ext_vector_type(16)));
typedef short v4i16_t __attribute__((ext_vector_type(4)));

constexpr int BATCH = 4, SEQ = 8192, D = 1024, FF = 2816, M = BATCH * SEQ, NQKVG = 3072;
constexpr float RMS_EPS = 1e-6f, LOG2E = 1.4426950408889634f;
constexpr int NWAVES = 8, NTHREADS = 512;

constexpr size_t MiB = 1u << 20;
constexpr size_t WS_CTL = 0;
constexpr size_t WS_WFI = 2 * MiB;
constexpr size_t WFI_STRIDE = 11 * MiB;
constexpr size_t WS_WFO = 46 * MiB;
constexpr size_t WFO_STRIDE = (size_t)1024 * 2816 * 2;
constexpr size_t WS_WCI = 68 * MiB;
constexpr size_t WS_WCO = 74 * MiB;
constexpr size_t WS_WQKV = 76 * MiB;
constexpr size_t WS_WAO = 94 * MiB;
constexpr size_t WS_BIAS = 96 * MiB;
constexpr size_t WS_SSQ = 98 * MiB;
constexpr size_t SSQ_STRIDE = 2 * MiB;
constexpr size_t WS_LSE = 110 * MiB;
constexpr size_t WS_HB = 112 * MiB;
constexpr size_t WS_OB = 176 * MiB;
constexpr size_t WS_R1 = 240 * MiB;
constexpr size_t WS_Q1 = 432 * MiB;
constexpr size_t WS_END = 496 * MiB;

constexpr int KCS = 384 * 16 + 16, VHS = 384 * 64 + 64;
constexpr int A_K0 = 0, A_V0 = 8 * KCS, A_BT = A_V0 + 2 * VHS, A_WSF = A_BT + 768, A_OST = A_WSF + 2048, A_END = A_OST + 32768;
constexpr int LDS_BYTES = 140 * 1024, MISC_OFF = LDS_BYTES - 64;
static_assert(A_END <= MISC_OFF && pg8::STAGE_BYTES <= LDS_BYTES, "lds");

__device__ __forceinline__ unsigned f2bf(float f) { unsigned u = __builtin_bit_cast(unsigned, f); return (u + 0x7fffu + ((u >> 16) & 1u)) >> 16; }
__device__ __forceinline__ unsigned pk2(float lo, float hi) { return f2bf(lo) | (f2bf(hi) << 16); }
__device__ __forceinline__ float bflo(unsigned u) { return __builtin_bit_cast(float, u << 16); }
__device__ __forceinline__ float bfhi(unsigned u) { return __builtin_bit_cast(float, u & 0xffff0000u); }
__device__ __forceinline__ float wave_sum(float v) {
#pragma unroll
    for (int o = 1; o < 64; o <<= 1) v += __shfl_xor(v, o);
    return v;
}
__device__ __forceinline__ float sum_x16_x32(float v) {
    float a = v, b = v;
    asm volatile("s_nop 1\n\tv_permlane16_swap_b32 %0, %1\n\ts_nop 1" : "+v"(a), "+v"(b));
    a = a + b; b = a;
    asm volatile("s_nop 1\n\tv_permlane32_swap_b32 %0, %1\n\ts_nop 1" : "+v"(a), "+v"(b));
    return a + b;
}
__device__ __forceinline__ float row_rstd(const float* ssq, int row) {
    const float* p = ssq + (size_t)row * 16;
    const f32x4 a = gld<f32x4>(p), b = gld<f32x4>(p + 4), c = gld<f32x4>(p + 8), d = gld<f32x4>(p + 12);
    const f32x4 s = (a + b) + (c + d);
    const float t = (s[0] + s[1]) + (s[2] + s[3]);
    return __builtin_amdgcn_rsqf(t * (1.f / 1024.f) + RMS_EPS);
}
__device__ __forceinline__ u32x4 pack8(const f32x4 a, const f32x4 b) {
    u32x4 w; w.x = cvt_pk_bf16(a[0], a[1]); w.y = cvt_pk_bf16(a[2], a[3]); w.z = cvt_pk_bf16(b[0], b[1]); w.w = cvt_pk_bf16(b[2], b[3]); return w;
}

struct EpiSwiglu {
    static constexpr bool PERM = true, PROBE2 = false, RSTD = true; static constexpr bool PEEL = true;
    bf16_t* O; const float* ssq;
    __device__ __forceinline__ float rstd_global(int row) const { return row_rstd(ssq, row); }
    __device__ __forceinline__ void operator()(const f32x4 (&acc)[2][2][4][2], const Unit& u, int wr, int wc, int fr, int fq, const LAS float* rt) const {
        const int row0 = u.pm * 256 + wr * 64 + fr;
        bf16_t* Ob = O + (size_t)(2 * u.pn + (wc >> 1)) * M * 64 + (wc & 1) * 32 + 8 * fq;
        float rsv[2][4];
#pragma unroll
        for (int ai = 0; ai < 2; ++ai)
#pragma unroll
            for (int m = 0; m < 4; ++m) rsv[ai][m] = rt ? rt[wr * 64 + fr + ai * 128 + m * 16] : row_rstd(ssq, row0 + ai * 128 + m * 16);
#pragma unroll
        for (int ai = 0; ai < 2; ++ai)
#pragma unroll
            for (int m = 0; m < 4; ++m) {
                const int row = row0 + ai * 128 + m * 16; const float rs = rsv[ai][m], nrs = -rs * LOG2E, irs2 = __builtin_amdgcn_rcpf(rs * rs);
                f32x4 o[2];
#pragma unroll
                for (int n = 0; n < 2; ++n) {
                    const f32x4 g = acc[ai][0][m][n], up = acc[ai][1][m][n];
#pragma unroll
                    for (int e = 0; e < 4; e += 2) {
                        typedef float f32x2 __attribute__((ext_vector_type(2)));
                        const f32x2 gg = (f32x2){g[e], g[e + 1]}, uu = (f32x2){up[e], up[e + 1]};
                        const f32x2 t = gg * nrs;
                        f32x2 ex; ex.x = __builtin_amdgcn_exp2f(t.x); ex.y = __builtin_amdgcn_exp2f(t.y);
                        const f32x2 d = ex * irs2 + irs2;
                        f32x2 r; r.x = __builtin_amdgcn_rcpf(d.x); r.y = __builtin_amdgcn_rcpf(d.y);
                        const f32x2 oo = (gg * uu) * r; o[n][e] = oo.x; o[n][e + 1] = oo.y; }
                }
                gst<u32x4>(Ob + (size_t)row * 64, pack8(o[0], o[1]));
            }
    }
};
struct EpiConvIn {
    static constexpr bool PERM = true, PROBE2 = false, RSTD = true; static constexpr bool PEEL = true;
    bf16_t* V; bf16_t* Bg; const float* ssq;
    __device__ __forceinline__ float rstd_global(int row) const { return row_rstd(ssq, row); }
    __device__ __forceinline__ void operator()(const f32x4 (&acc)[2][2][4][2], const Unit& u, int wr, int wc, int fr, int fq, const LAS float* rt) const {
        const int row0 = u.pm * 256 + wr * 64 + fr;
#pragma unroll
        for (int ai = 0; ai < 2; ++ai)
#pragma unroll
            for (int m = 0; m < 4; ++m) {
                const int row = row0 + ai * 128 + m * 16; const float rs = rt ? rt[wr * 64 + fr + ai * 128 + m * 16] : row_rstd(ssq, row);
                if (u.pn < 8) {
                    const float r2 = rs * rs;
                    const f32x4 o0 = acc[ai][0][m][0] * acc[ai][1][m][0] * r2, o1 = acc[ai][0][m][1] * acc[ai][1][m][1] * r2;
                    gst<u32x4>(V + (size_t)row * D + u.pn * 128 + wc * 32 + 8 * fq, pack8(o0, o1));
                } else {
#pragma unroll
                    for (int bj = 0; bj < 2; ++bj)
                        gst<u32x4>(Bg + (size_t)row * D + (u.pn - 8) * 256 + bj * 128 + wc * 32 + 8 * fq, pack8(acc[ai][bj][m][0] * rs, acc[ai][bj][m][1] * rs));
                }
            }
    }
};
struct EpiQKV {
    static constexpr bool PERM = true, PROBE2 = false, RSTD = true; static constexpr bool PEEL = true;
    bf16_t* Oq; bf16_t* Okv; const float* ssq; const float* qg; const float* kg; int rsh;
    __device__ __forceinline__ float rstd_global(int row) const { return row_rstd(ssq, row); }
    __device__ __forceinline__ void operator()(const f32x4 (&acc)[2][2][4][2], const Unit& u, int wr, int wc, int fr, int fq, const LAS float* rt) const {
        const int row0 = u.pm * 256 + wr * 64 + fr, kind = u.pn >> 2;
        f32x4 gv[2][2];
#pragma unroll
        for (int bj = 0; bj < 2; ++bj)
#pragma unroll
            for (int n = 0; n < 2; ++n) {
                if (kind < 2) { const float* gp = (kind == 0 ? qg : kg) + 32 * bj + 8 * fq + 4 * n; const float sc = kind == 0 ? 0.125f * LOG2E : 1.f; gv[bj][n] = gld<f32x4>(gp) * sc; }
                else gv[bj][n] = (f32x4){1.f, 1.f, 1.f, 1.f};
            }
#pragma unroll
        for (int ai = 0; ai < 2; ++ai)
#pragma unroll
            for (int m = 0; m < 4; ++m) {
                const int row = row0 + ai * 128 + m * 16; const float rs = rt ? rt[wr * 64 + fr + ai * 128 + m * 16] : row_rstd(ssq, row);
                f32x4 v[2][2]; float ss = 0.f;
#pragma unroll
                for (int bj = 0; bj < 2; ++bj)
#pragma unroll
                    for (int n = 0; n < 2; ++n) { v[bj][n] = acc[ai][bj][m][n] * rs; const f32x4 q = v[bj][n] * v[bj][n]; ss += (q[0] + q[1]) + (q[2] + q[3]); }
                ss = sum_x16_x32(ss);
                const float sc = kind < 2 ? __builtin_amdgcn_rsqf(ss * (1.f / 64.f) + RMS_EPS) : 1.f;
                const int tt = row & (SEQ - 1); const int prow = (row & ~(SEQ - 1)) + (tt & ((1 << rsh) - 1)) * (SEQ >> rsh) + (tt >> rsh);
#pragma unroll
                for (int bj = 0; bj < 2; ++bj)
                    gst<u32x4>((kind == 0 ? Oq : Okv + (size_t)(kind - 1) * 16 * M * 64) + ((size_t)(4 * (u.pn & 3) + wc) * M + prow) * 64 + 32 * bj + 8 * fq, pack8(v[bj][0] * sc * gv[bj][0], v[bj][1] * sc * gv[bj][1]));
            }
    }
};
struct EpiResid {
    static constexpr bool PERM = true, PROBE2 = false, RSTD = false; static constexpr bool PEEL = false;
    float* out32; bf16_t* hb; float* ssq; float scale;
    __device__ __forceinline__ void operator()(const f32x4 (&acc)[2][2][4][2], const Unit& u, int wr, int wc, int fr, int fq) const {
        const int row0 = u.pm * 256 + wr * 64 + fr, col0 = u.pn * 256 + wc * 32 + 8 * fq;
        bf16_t* hbk = hb + (size_t)(u.pn * 4 + (wc >> 1)) * M * 64 + (wc & 1) * 32 + 8 * fq; constexpr size_t BJS = (size_t)2 * M * 64;
        const bf16_t* hrow = hbk + (size_t)row0 * 64;
#pragma unroll
        for (int ai = 0; ai < 2; ++ai) {
            u32x4 bq[4][2];
#pragma unroll
            for (int m = 0; m < 4; ++m)
#pragma unroll
                for (int bj = 0; bj < 2; ++bj) bq[m][bj] = gld<u32x4>(hrow + bj * BJS + (size_t)(ai * 128 + m * 16) * 64);
            asm volatile("" ::: "memory");
#pragma unroll
            for (int m = 0; m < 4; ++m) {
                const int row = row0 + ai * 128 + m * 16; const size_t off = (size_t)row * D + col0; float ss = 0.f;
#pragma unroll
                for (int bj = 0; bj < 2; ++bj) {
                    const u32x4 q = bq[m][bj];
                    const f32x4 b0 = (f32x4){bflo(q.x), bfhi(q.x), bflo(q.y), bfhi(q.y)}, b1 = (f32x4){bflo(q.z), bfhi(q.z), bflo(q.w), bfhi(q.w)};
                    const f32x4 h0 = b0 + acc[ai][bj][m][0] * scale, h1 = b1 + acc[ai][bj][m][1] * scale;
                    if (out32) { gst<f32x4>(out32 + off + bj * 128, h0); gst<f32x4>(out32 + off + bj * 128 + 4, h1); }
                    else {
                        const f32x4 q0 = h0 * h0, q1 = h1 * h1; ss += ((q0[0] + q0[1]) + (q0[2] + q0[3])) + ((q1[0] + q1[1]) + (q1[2] + q1[3]));
                        gst<u32x4>((bf16_t*)hrow + bj * BJS + (size_t)(ai * 128 + m * 16) * 64, pack8(h0, h1));
                    }
                }
                if (!out32) { ss = sum_x16_x32(ss); if (fq == 0) gst<float>(ssq + (size_t)row * 16 + u.pn * 4 + wc, ss); }
            }
            asm volatile("" ::: "memory");
        }
    }
};

__device__ __forceinline__ void transpose_item(const float* W, int K, int N, int n0src, const float* gk, bf16_t* WT, int drow0, LAS float* scr, int kb, int lane) {
    const int k0 = 64 * kb;
    float tv[32];
#pragma unroll
    for (int i = 0; i < 32; ++i) { const int kk = 2 * i + (lane >> 5); tv[i] = W[(size_t)(k0 + kk) * N + n0src + (lane & 31)]; }
    if (gk) {
#pragma unroll
        for (int i = 0; i < 32; ++i) tv[i] *= gk[k0 + 2 * i + (lane >> 5)];
    }
#pragma unroll
    for (int i = 0; i < 32; ++i) scr[(2 * i + (lane >> 5)) * 33 + (lane & 31)] = tv[i];
    asm volatile("s_waitcnt lgkmcnt(0)" ::: "memory");
    const int c = lane & 7;
#pragma unroll
    for (int j = 0; j < 4; ++j) { const int n = (lane >> 3) + 8 * j; const LAS float* s = scr + (8 * c) * 33 + n;
        u32x4 o; o.x = pk2(s[0 * 33], s[1 * 33]); o.y = pk2(s[2 * 33], s[3 * 33]); o.z = pk2(s[4 * 33], s[5 * 33]); o.w = pk2(s[6 * 33], s[7 * 33]);
        gst<u32x4>(WT + (size_t)(drow0 + n) * K + k0 + 8 * c, o); }
    asm volatile("s_waitcnt lgkmcnt(0)" ::: "memory");
}

struct Args {
    const float* in[16]; float* out; unsigned char* ws; int step_lo, step_hi;
};

__device__ __forceinline__ int t5_bucket(int dist) {
    if (dist < 16) return dist;
    const float nf = (float)dist;
    int large = 16 + (int)(logf(nf / 16.f) / 4.852030263919617f * 16.f);
    return large < 31 ? large : 31;
}

__device__ __forceinline__ void prologue(const Args& a, LAS unsigned char* lds) {
    int tid = threadIdx.x; asm volatile("" : "+v"(tid));
    const int lane = tid & 63, wave = __builtin_amdgcn_readfirstlane(tid >> 6);
    LAS float* scr = (LAS float*)(lds + wave * 16384);
    const int gw = blockIdx.x * NWAVES + wave, NGW = gridDim.x * NWAVES;
    unsigned char* ws = a.ws;
    constexpr int I_FI = 16 * 176, I_FO = 44 * 32, I_CI = 16 * 96, I_CO = 16 * 32, I_QKV = 16 * 288, I_AO = 16 * 32;
    constexpr int NITEMS = 4 * I_FI + 4 * I_FO + I_CI + I_CO + I_QKV + I_AO;
    for (int it = gw; it < NITEMS; it += NGW) {
        int r = it;
        if (r < 4 * I_FI) {
            const int s = r / I_FI; r -= s * I_FI; const int kb = r / 176, rb = r % 176, layer = s >> 1, second = s & 1;
            const float* W = a.in[second ? 14 : 2] + (size_t)layer * D * 2 * FF; const float* gk = a.in[second ? 13 : 1] + layer * D;
            const int pn = rb >> 3, half = (rb >> 2) & 1, j32 = rb & 3;
            transpose_item(W, D, 2 * FF, half * FF + pn * 128 + j32 * 32, gk, (bf16_t*)(ws + WS_WFI + s * WFI_STRIDE), rb * 32, scr, kb, lane); continue; }
        r -= 4 * I_FI;
        if (r < 4 * I_FO) {
            const int s = r / I_FO; r -= s * I_FO; const int kb = r / 32, rb = r % 32, layer = s >> 1, second = s & 1;
            const float* W = a.in[second ? 15 : 3] + (size_t)layer * FF * D;
            transpose_item(W, FF, D, rb * 32, nullptr, (bf16_t*)(ws + WS_WFO + s * WFO_STRIDE), rb * 32, scr, kb, lane); continue; }
        r -= 4 * I_FO;
        if (r < I_CI) {
            const int kb = r / 96, rb = r % 96; int src;
            if (rb < 64) { const int pn = rb >> 3, half = (rb >> 2) & 1, j32 = rb & 3; src = 1024 + half * 1024 + pn * 128 + j32 * 32; } else src = (rb - 64) * 32;
            transpose_item(a.in[5], D, 3 * D, src, a.in[4], (bf16_t*)(ws + WS_WCI), rb * 32, scr, kb, lane); continue; }
        r -= I_CI;
        if (r < I_CO) { const int kb = r / 32, rb = r % 32; transpose_item(a.in[7], D, D, rb * 32, nullptr, (bf16_t*)(ws + WS_WCO), rb * 32, scr, kb, lane); continue; }
        r -= I_CO;
        if (r < I_QKV) {
            const int kb = r / 288, rb = r % 288, g = rb / 96, rbl = rb % 96, pn = rbl >> 3, bj = (rbl >> 2) & 1, wc = rbl & 3;
            transpose_item(a.in[8], D, 9 * D, g * 3072 + pn * 256 + 64 * wc + 32 * bj, a.in[4] + D, (bf16_t*)(ws + WS_WQKV), rb * 32, scr, kb, lane); continue; }
        r -= I_QKV;
        { const int kb = r / 32, rb = r % 32; transpose_item(a.in[11], D, D, rb * 32, nullptr, (bf16_t*)(ws + WS_WAO), rb * 32, scr, kb, lane); }
    }
    bf16_t* HB = (bf16_t*)(ws + WS_HB); float* ssq0 = (float*)(ws + WS_SSQ);
    for (int m0 = 2 * gw; m0 < M; m0 += 2 * NGW) {
        f32x4 v[2][4];
#pragma unroll
        for (int q = 0; q < 2; ++q) { const f32x4* xr = (const f32x4*)(a.in[0] + (size_t)(m0 + q) * D) + lane;
#pragma unroll
            for (int j = 0; j < 4; ++j) v[q][j] = xr[64 * j]; }
#pragma unroll
        for (int q = 0; q < 2; ++q) {
            float s = 0.f;
#pragma unroll
            for (int j = 0; j < 4; ++j) s += (v[q][j].x * v[q][j].x + v[q][j].y * v[q][j].y) + (v[q][j].z * v[q][j].z + v[q][j].w * v[q][j].w);
            s = wave_sum(s);
#pragma unroll
            for (int j = 0; j < 4; ++j) {
                unsigned long long* o8 = (unsigned long long*)(HB + ((size_t)((lane >> 4) + 4 * j) * M + (m0 + q)) * 64 + ((4 * lane) & 63));
                *o8 = (unsigned long long)pk2(v[q][j].x, v[q][j].y) | ((unsigned long long)pk2(v[q][j].z, v[q][j].w) << 32); }
            if (lane < 16) ssq0[(size_t)(m0 + q) * 16 + lane] = lane == 0 ? s : 0.f;
        }
    }
    float* BT = (float*)(ws + WS_BIAS);
    for (int i = blockIdx.x * NTHREADS + tid; i < 3 * 16 * 192; i += gridDim.x * NTHREADS) {
        const int g = i / (16 * 192), h = (i / 192) % 16, idx = i % 192, step = idx - 32;
        float v = -INFINITY;
        if (step >= 0 && step <= 128) { const int dist = step << (2 * g); v = a.in[12][t5_bucket(dist) * 48 + g * 16 + h] * LOG2E; }
        BT[i] = v;
    }
}

__device__ __forceinline__ void conv_taps(const u32x4 v0, const u32x4 v1, const u32x4 v2, const u32x4 bb, const f32x4 (&w)[3][2], bf16_t* yp) {
    f32x4 oa, ob;
#pragma unroll
    for (int e = 0; e < 4; ++e) {
        const unsigned a0 = v0[e], a1 = v1[e], a2 = v2[e], b = bb[e];
        const float wl0 = e < 2 ? w[0][0][2 * e] : w[0][1][2 * e - 4], wh0 = e < 2 ? w[0][0][2 * e + 1] : w[0][1][2 * e - 3];
        const float wl1 = e < 2 ? w[1][0][2 * e] : w[1][1][2 * e - 4], wh1 = e < 2 ? w[1][0][2 * e + 1] : w[1][1][2 * e - 3];
        const float wl2 = e < 2 ? w[2][0][2 * e] : w[2][1][2 * e - 4], wh2 = e < 2 ? w[2][0][2 * e + 1] : w[2][1][2 * e - 3];
        const float lo = bflo(b) * (wl0 * bflo(a0) + wl1 * bflo(a1) + wl2 * bflo(a2));
        const float hi = bfhi(b) * (wh0 * bfhi(a0) + wh1 * bfhi(a1) + wh2 * bfhi(a2));
        if (e < 2) { oa[2 * e] = lo; oa[2 * e + 1] = hi; } else { ob[2 * e - 4] = lo; ob[2 * e - 3] = hi; }
    }
    gst<u32x4>(yp, pack8(oa, ob));
}
__device__ __forceinline__ void conv_ew(const bf16_t* __restrict__ V, const bf16_t* __restrict__ Bg, bf16_t* __restrict__ Y, const float* __restrict__ cw) {
    const int nth = gridDim.x * NTHREADS; int tid = threadIdx.x; asm volatile("" : "+v"(tid));
    constexpr int RUN = 32;
    for (int i = blockIdx.x * NTHREADS + tid; i < (M / RUN) * 128; i += nth) {
        const int c8 = (i & 127) * 8, r0 = (i >> 7) * RUN, t0 = r0 & (SEQ - 1);
        f32x4 w[3][2];
#pragma unroll
        for (int l = 0; l < 3; ++l) { w[l][0] = gld<f32x4>(cw + l * D + c8); w[l][1] = gld<f32x4>(cw + l * D + c8 + 4); }
        const size_t off0 = (size_t)r0 * D + c8;
        const u32x4 z = (u32x4){0u, 0u, 0u, 0u};
        u32x4 vm1 = t0 >= 1 ? gld<u32x4>(V + off0 - D) : z, vm2 = t0 >= 2 ? gld<u32x4>(V + off0 - 2 * D) : z;
        for (int r = 0; r < RUN; r += 4) {
            u32x4 v[4], b[4];
#pragma unroll
            for (int j = 0; j < 4; ++j) { v[j] = gld<u32x4>(V + off0 + (size_t)(r + j) * D); b[j] = gld<u32x4>(Bg + off0 + (size_t)(r + j) * D); }
            conv_taps(v[0], vm1, vm2, b[0], w, Y + off0 + (size_t)(r + 0) * D);
            conv_taps(v[1], v[0], vm1, b[1], w, Y + off0 + (size_t)(r + 1) * D);
            conv_taps(v[2], v[1], v[0], b[2], w, Y + off0 + (size_t)(r + 2) * D);
            conv_taps(v[3], v[2], v[1], b[3], w, Y + off0 + (size_t)(r + 3) * D);
            vm1 = v[3]; vm2 = v[2];
        }
    }
}

__device__ __forceinline__ int crow(int r, int hi) { return (r & 3) + 8 * (r >> 2) + 4 * hi; }
__device__ __forceinline__ v4i16_t vtr(const LAS unsigned char* p) { return __builtin_amdgcn_ds_read_tr16_b64_v4i16((LAS v4i16_t*)p); }

typedef unsigned u32x2 __attribute__((ext_vector_type(2)));
__device__ __forceinline__ void attn_load(const bf16_t* qp, const bf16_t* kvp, const float* biasG, const int rsh, const int unit, const int tid, const int w, const int r32, const int hi,
                                          u32x4 (&kr)[6], u32x4 (&vr)[6], bf16x8 (&qn)[4], float& bn) {
    const int per = 32 >> rsh, RL = per < 8 ? per : 8;
    const int idx32 = unit & 31, np = idx32 & (per - 1), s = idx32 >> (5 - rsh), h = (unit >> 5) & 15, b = unit >> 9, j = np & (RL - 1);
    const size_t rowb = (size_t)b * SEQ;
#pragma unroll
    for (int it = 0; it < 6; ++it) {
        const int idx = tid + 512 * it, kl = idx >> 3, ch = idx & 7;
        const int mpos = j == 0 ? 256 * np - 128 + kl : 256 * np + kl;
        const bool want = j == 0 || it < 4;
        if (want) {
            if (mpos >= 0) { const bf16_t* p = kvp + ((size_t)h * M + rowb + (size_t)s * (SEQ >> rsh) + mpos) * 64 + ch * 8; kr[it] = gld<u32x4>(p); vr[it] = gld<u32x4>(p + (size_t)16 * M * 64); }
            else { kr[it] = (u32x4){0u, 0u, 0u, 0u}; vr[it] = (u32x4){0u, 0u, 0u, 0u}; }
        }
    }
    { const int mq = 256 * np + 32 * w + r32; const bf16_t* p = qp + ((size_t)h * M + rowb + (size_t)s * (SEQ >> rsh) + mq) * 64 + hi * 8;
#pragma unroll
      for (int d0 = 0; d0 < 4; ++d0) qn[d0] = gld<bf16x8>(p + 16 * d0); }
    bn = tid < 192 ? gld<float>(biasG + h * 192 + tid) : 0.f;
}

__device__ __forceinline__ void attn_phase(LAS unsigned char* lds, const bf16_t* qp, const bf16_t* kvp, bf16_t* obuf, float* lse, const float* biasG, const int gi, const int rsh, const int G) {
    int tid = threadIdx.x; asm volatile("" : "+v"(tid));
    const int lane = tid & 63, r32 = lane & 31, hi = lane >> 5, w = __builtin_amdgcn_readfirstlane(tid >> 6);
    const int per = 32 >> rsh, RL = per < 8 ? per : 8;
    int unit = (int)blockIdx.x * RL; if (unit >= 2048) return;
    u32x4 kr[6], vr[6]; bf16x8 qn[4]; float bn;
    attn_load(qp, kvp, biasG, rsh, unit, tid, w, r32, hi, kr, vr, qn, bn);
    if (w >= 4) __builtin_amdgcn_s_setprio(1);
    for (;;) {
        const int idx32 = unit & 31, np = idx32 & (per - 1), s = idx32 >> (5 - rsh), h = (unit >> 5) & 15, b = unit >> 9, j = np & (RL - 1);
        const size_t rowb = (size_t)b * SEQ;
        if (tid < 192) ((LAS float*)(lds + A_BT))[tid] = bn;
        const int wbase = j == 0 ? 0 : ((2 * j + 1) % 3) * 128;
#pragma unroll
        for (int it = 0; it < 6; ++it) {
            const int idx = tid + 512 * it, kl = idx >> 3, ch = idx & 7;
            if (j == 0 || it < 4) {
                int row = wbase + kl; row = row >= 384 ? row - 384 : row;
                *(LAS u32x4*)(lds + A_K0 + ch * KCS + row * 16) = kr[it];
                *(LAS u32x4*)(lds + A_V0 + (ch >> 2) * VHS + row * 64 + (ch & 3) * 16) = vr[it];
            }
        }
        bf16x8 qr[4];
#pragma unroll
        for (int d0 = 0; d0 < 4; ++d0) qr[d0] = qn[d0];
        asm volatile("s_waitcnt lgkmcnt(0)\n\ts_barrier" ::: "memory");
        const int nu = ((unit + 1) & (RL - 1)) ? unit + 1 : unit + 1 + (G - 1) * RL; const bool has_next = nu < 2048;
        const int mq = 256 * np + 32 * w + r32; const size_t growq = rowb + ((size_t)mq << rsh) + s;
        float lp = 0.f; if (gi > 0) lp = gld<float>(lse + growq * 16 + h);
        if (has_next) attn_load(qp, kvp, biasG, rsh, nu, tid, w, r32, hi, kr, vr, qn, bn);
        const int c0 = ((2 * j) % 3) * 4 + w;
        int sc[5];
#pragma unroll
        for (int cc = 0; cc < 5; ++cc) { const int t = c0 + cc; sc[cc] = t >= 12 ? t - 12 : t; }
        f32x16 p[5];
        const LAS float* bt = (const LAS float*)(lds + A_BT);
        const LAS unsigned char* kbase = lds + A_K0 + hi * KCS + r32 * 16;
#pragma unroll
        for (int c2 = 0; c2 < 5; c2 += 2) {
            bf16x8 ka[4], kb[4];
#pragma unroll
            for (int d0 = 0; d0 < 4; ++d0) { ka[d0] = *(const LAS bf16x8*)(kbase + 2 * d0 * KCS + sc[c2] * 512); if (c2 + 1 < 5) kb[d0] = *(const LAS bf16x8*)(kbase + 2 * d0 * KCS + sc[c2 + 1 < 5 ? c2 + 1 : c2] * 512); }
#pragma unroll
            for (int q = 0; q < 2; ++q) { const int cc = c2 + q; if (cc < 5) { const bool dead = (np == 0) && (w + cc < 4);
                const LAS float* bq_ = dead ? bt + 27 - (160 + r32 - 32 * cc - 4 * hi) : bt;
#pragma unroll
                for (int r = 0; r < 16; ++r) p[cc][r] = bq_[160 + r32 - 32 * cc - crow(r, hi)]; } }
            __builtin_amdgcn_sched_barrier(0);
#pragma unroll
            for (int d0 = 0; d0 < 4; ++d0) {
                p[c2] = __builtin_amdgcn_mfma_f32_32x32x16_bf16(ka[d0], qr[d0], p[c2], 0, 0, 0);
                if (c2 + 1 < 5) p[c2 + 1 < 5 ? c2 + 1 : c2] = __builtin_amdgcn_mfma_f32_32x32x16_bf16(kb[d0], qr[d0], p[c2 + 1 < 5 ? c2 + 1 : c2], 0, 0, 0);
            }
            __builtin_amdgcn_sched_barrier(0);
        }
        float mx = p[0][0];
#pragma unroll
        for (int cc = 0; cc < 5; ++cc)
#pragma unroll
            for (int r = 0; r < 16; ++r) mx = fmaxf(mx, p[cc][r]);
        mx = fmaxf(mx, __shfl_xor(mx, 32));
        typedef float f32x2 __attribute__((ext_vector_type(2)));
        f32x2 l2 = (f32x2){0.f, 0.f};
#define ATT_EXP8(cc_, r0_) do { _Pragma("unroll") for (int r = (r0_); r < (r0_) + 8; r += 2) { \
                const f32x2 d_ = (f32x2){p[cc_][r], p[cc_][r + 1]} - mx; f32x2 e_; e_.x = __builtin_amdgcn_exp2f(d_.x); e_.y = __builtin_amdgcn_exp2f(d_.y); \
                p[cc_][r] = e_.x; p[cc_][r + 1] = e_.y; l2 += e_; } } while (0)
        ATT_EXP8(0, 0); ATT_EXP8(0, 8);
        bf16_t* og = obuf + ((size_t)h * M + growq) * 64 + 4 * hi;
        u32x2 prev[2][4];
        f32x16 o[2];
#pragma unroll
        for (int r = 0; r < 16; ++r) { o[0][r] = 0.f; o[1][r] = 0.f; }
        const LAS unsigned char* vb = lds + A_V0 + ((lane >> 4) & 1) * 32 + (lane & 3) * 8 + (4 * hi + ((lane & 15) >> 2)) * 64;
#pragma unroll
        for (int cc = 0; cc < 5; ++cc)
#pragma unroll
            for (int gk = 0; gk < 2; ++gk) {
                if (cc == 3 && gk == 0 && gi > 0) {
#pragma unroll
                    for (int d0 = 0; d0 < 2; ++d0)
#pragma unroll
                        for (int rq = 0; rq < 4; ++rq) prev[d0][rq] = gld<u32x2>(og + 32 * d0 + 8 * rq);
                }
                if (cc + 1 < 5) ATT_EXP8(cc + 1 < 5 ? cc + 1 : cc, 8 * gk);
                u32x4 pw; pw.x = cvt_pk_bf16(p[cc][8 * gk + 0], p[cc][8 * gk + 1]); pw.y = cvt_pk_bf16(p[cc][8 * gk + 2], p[cc][8 * gk + 3]);
                pw.z = cvt_pk_bf16(p[cc][8 * gk + 4], p[cc][8 * gk + 5]); pw.w = cvt_pk_bf16(p[cc][8 * gk + 6], p[cc][8 * gk + 7]);
                const bf16x8 pa = __builtin_bit_cast(bf16x8, pw);
                const LAS unsigned char* vrow = vb + sc[cc] * 2048 + gk * 1024;
#pragma unroll
                for (int d0 = 0; d0 < 2; ++d0) {
                    const v4i16_t lo = vtr(vrow + d0 * VHS), hh = vtr(vrow + d0 * VHS + 512);
                    const bf16x8 vf = (bf16x8){lo[0], lo[1], lo[2], lo[3], hh[0], hh[1], hh[2], hh[3]};
                    o[d0] = __builtin_amdgcn_mfma_f32_32x32x16_bf16(vf, pa, o[d0], 0, 0, 0);
                }
            }
#undef ATT_EXP8
        float l = l2.x + l2.y;
        l += __shfl_xor(l, 32);
        const float lse_new = mx + __builtin_amdgcn_logf(l);
        float ca = 0.f, cb = 1.0f / l, lse_out = lse_new;
        if (gi > 0) {
            const float mm = fmaxf(lp, lse_new);
            const float wa = __builtin_amdgcn_exp2f(lp - mm), wb = __builtin_amdgcn_exp2f(lse_new - mm), tot = wa + wb, it = 1.0f / tot;
            ca = wa * it; cb = wb * it / l; lse_out = mm + __builtin_amdgcn_logf(tot);
        }
        if (gi < 2 && hi == 0) gst<float>(lse + growq * 16 + h, lse_out);
#pragma unroll
        for (int d0 = 0; d0 < 2; ++d0)
#pragma unroll
            for (int rq = 0; rq < 4; ++rq) {
                float v0 = o[d0][4 * rq] * cb, v1 = o[d0][4 * rq + 1] * cb, v2 = o[d0][4 * rq + 2] * cb, v3 = o[d0][4 * rq + 3] * cb;
                if (gi > 0) { const u32x2 pv = prev[d0][rq]; v0 += ca * bflo(pv.x); v1 += ca * bfhi(pv.x); v2 += ca * bflo(pv.y); v3 += ca * bfhi(pv.y); }
                u32x2 ov; ov.x = cvt_pk_bf16(v0, v1); ov.y = cvt_pk_bf16(v2, v3);
                gst<u32x2>(og + 32 * d0 + 8 * rq, ov);
            }
        asm volatile("s_waitcnt lgkmcnt(0)\n\ts_barrier" ::: "memory");
        if (!has_next) break;
        unit = nu;
    }
    __builtin_amdgcn_s_setprio(0);
}

#define XB_TMO      128
#define XB_XCNT(j)  (256  + 64 * (j))
#define XB_XSUB(j)  (1280 + 64 * (j))
#define XB_XGEN(j)  (2304 + 64 * (j))
#define XB_TOP      3328
#define XB_TOPGEN   3392
#define XCD_BAR_WORDS 3456
#define XB_SPIN_CAP (1u << 18)
__device__ __forceinline__ unsigned xb_ld(unsigned* p)              { return __hip_atomic_load(p, __ATOMIC_RELAXED, __HIP_MEMORY_SCOPE_AGENT); }
__device__ __forceinline__ unsigned xb_add(unsigned* p, unsigned v) { return __hip_atomic_fetch_add(p, v, __ATOMIC_RELAXED, __HIP_MEMORY_SCOPE_AGENT); }
__device__ __forceinline__ unsigned xb_xcc_id() { return (unsigned)__builtin_amdgcn_s_getreg((3 << 11) | 20) & 0xFu; }
#define XB_SPIN(cond, bar) do { unsigned _sp = 0; while (cond) { __builtin_amdgcn_s_sleep(1); \
    if ((++_sp & 255u) == 0u) { if (xb_ld(&(bar)[XB_TMO])) break; if (_sp > XB_SPIN_CAP) { atomicAdd(&(bar)[XB_TMO], 1u); break; } } } } while (0)
struct XcdBarrier { unsigned* bar; unsigned x; volatile LAS unsigned* st; };
__device__ __forceinline__ XcdBarrier xcd_barrier_post(unsigned* bar, volatile LAS unsigned* st) {
    XcdBarrier b; b.bar = bar; b.x = xb_xcc_id(); b.st = st;
    if (threadIdx.x == 0) (void)xb_add(&bar[XB_XCNT(b.x)], 1u);
    return b;
}
__device__ __forceinline__ void xcd_barrier_complete(unsigned* bar, unsigned x, unsigned& nloc, unsigned& nx) {
    const unsigned G = gridDim.x * gridDim.y * gridDim.z;
    unsigned sum, cnt, mine, sp = 0u;
    for (;;) {
        sum = 0u; cnt = 0u; mine = 0u;
#pragma unroll
        for (unsigned j = 0; j < 16; ++j) { const unsigned c = xb_ld(&bar[XB_XCNT(j)]); sum += c; cnt += (c > 0u) ? 1u : 0u; mine = (j == x) ? c : mine; }
        if (sum == G) break;
        __builtin_amdgcn_s_sleep(1);
        if ((++sp & 255u) == 0u) { if (xb_ld(&bar[XB_TMO])) break; if (sp > XB_SPIN_CAP) { atomicAdd(&bar[XB_TMO], 1u); break; } }
    }
    nloc = mine > 0u ? mine : 1u; nx = cnt > 0u ? cnt : 1u;
}
__device__ __forceinline__ void xcd_barrier(const XcdBarrier& b) {
    asm volatile("s_waitcnt vmcnt(0)" ::: "memory");
    __syncthreads();
    if (threadIdx.x == 0) {
        unsigned* bar = b.bar;
        __builtin_amdgcn_s_waitcnt(0);
        unsigned nloc = b.st[0], nx = b.st[1];
        if (nloc == 0u) { xcd_barrier_complete(bar, b.x, nloc, nx); b.st[0] = nloc; b.st[1] = nx; }
        const unsigned old = xb_add(&bar[XB_XSUB(b.x)], 1u);
        const unsigned gen = old / nloc;
        if (old + 1u == (gen + 1u) * nloc) {
            __builtin_amdgcn_fence(__ATOMIC_RELEASE, "agent");
            asm volatile("s_waitcnt vmcnt(0)" ::: "memory");
            const unsigned og = xb_add(&bar[XB_TOP], 1u);
            const unsigned tg = og / nx;
            if (og + 1u == (tg + 1u) * nx) xb_add(&bar[XB_TOPGEN], 1u);
            else XB_SPIN(xb_ld(&bar[XB_TOPGEN]) == tg, bar);
            __builtin_amdgcn_fence(__ATOMIC_ACQUIRE, "agent");
            xb_add(&bar[XB_XGEN(b.x)], 1u);
            asm volatile("s_waitcnt vmcnt(0)" ::: "memory");
        } else {
            XB_SPIN(xb_ld(&bar[XB_XGEN(b.x)]) == gen, bar);
            __builtin_amdgcn_fence(__ATOMIC_ACQUIRE, "agent");
            asm volatile("s_waitcnt vmcnt(0)" ::: "memory");
        }
    }
    __syncthreads();
}

__global__ void __launch_bounds__(NTHREADS, 2) fwd_megakernel(Args a) {
    extern __shared__ __attribute__((aligned(16))) unsigned char lds_raw[];
    LAS unsigned char* lds = (LAS unsigned char*)lds_raw;
    const int G = gridDim.x;
    volatile LAS unsigned* MISC = (volatile LAS unsigned*)(lds + MISC_OFF);
    if (threadIdx.x < 16) MISC[threadIdx.x] = 0u;
    __syncthreads();
    XcdBarrier bar; bar.bar = (unsigned*)(a.ws + WS_CTL); bar.x = 0; bar.st = MISC;
    if (a.step_hi - a.step_lo > 1) bar = xcd_barrier_post((unsigned*)(a.ws + WS_CTL), MISC);
#define SSQ(i) ((float*)(ws + WS_SSQ + (size_t)(i) * SSQ_STRIDE))
#define WFI(s) ((const bf16_t*)(ws + WS_WFI + (size_t)(s) * WFI_STRIDE))
#define WFO(s) ((const bf16_t*)(ws + WS_WFO + (size_t)(s) * WFO_STRIDE))
    for (int step = a.step_lo; step < a.step_hi; ++step) {
        unsigned char* ws = a.ws; asm volatile("" : "+s"(ws));
        bf16_t* HB = (bf16_t*)(ws + WS_HB); bf16_t* OB = (bf16_t*)(ws + WS_OB); bf16_t* R1 = (bf16_t*)(ws + WS_R1);
        float* LSE = (float*)(ws + WS_LSE);
        bf16_t* CV = R1; bf16_t* CB = R1 + (size_t)M * D; bf16_t* CY = R1 + (size_t)2 * M * D;
        int kind = 0, p0 = 0;
        switch (step) {
            case 0: kind = 0; break;
            case 1: kind = 1; p0 = 0; break;
            case 2: kind = 2; p0 = 0; break;
            case 3: kind = 3; break;
            case 4: kind = 4; break;
            case 5: kind = 2; p0 = 4; break;
            case 6: kind = 1; p0 = 1; break;
            case 7: kind = 2; p0 = 1; break;
            case 8: kind = 1; p0 = 2; break;
            case 9: kind = 2; p0 = 2; break;
            case 10: kind = 5; p0 = 0; break;
            case 11: kind = 6; p0 = 0; break;
            case 12: kind = 5; p0 = 1; break;
            case 13: kind = 6; p0 = 1; break;
            case 14: kind = 5; p0 = 2; break;
            case 15: kind = 6; p0 = 2; break;
            case 16: kind = 2; p0 = 5; break;
            case 17: kind = 1; p0 = 3; break;
            default: kind = 2; p0 = 3; break;
        }
        const int nrep = (step == PROBE_STEP) ? PROBE_REP : 1;
        for (int rep = 0; rep < nrep; ++rep) {
        if (kind == 0) {
            prologue(a, lds);
        } else if (kind == 1) {
            const int si = p0 == 0 ? 0 : p0 == 1 ? 2 : p0 == 2 ? 3 : 5;
            pg8::Gemm g{HB, WFI(p0), M, 2 * FF, D, 128, (size_t)M * 128}; pg8::StaticOrder S; S.init(M, 2 * FF, G, (int)blockIdx.x);
            EpiSwiglu E{R1, SSQ(si)};
            pg8::gemm_phase<EpiSwiglu, pg8::StaticOrder, true, true>(lds, g, S, E);
        } else if (kind == 2) {
            pg8::Gemm g; EpiResid E;
            if (p0 < 4) {
                g = pg8::Gemm{R1, WFO(p0), M, D, FF, 128, (size_t)M * 128};
                const int so = p0 == 0 ? 1 : p0 == 1 ? 3 : 4;
                E = EpiResid{p0 == 3 ? a.out : nullptr, HB, SSQ(so), 0.5f};
            } else if (p0 == 4) {
                g = pg8::Gemm{CY, (const bf16_t*)(ws + WS_WCO), M, D, D, 2 * D, 128};
                E = EpiResid{nullptr, HB, SSQ(2), 1.0f};
            } else {
                g = pg8::Gemm{OB, (const bf16_t*)(ws + WS_WAO), M, D, D, 128, (size_t)M * 128};
                E = EpiResid{nullptr, HB, SSQ(5), 1.0f};
            }
            pg8::StaticOrder S; S.init(M, D, G, (int)blockIdx.x);
            pg8::gemm_phase<EpiResid, pg8::StaticOrder, true, true>(lds, g, S, E);
        } else if (kind == 3) {
            pg8::Gemm g{HB, (const bf16_t*)(ws + WS_WCI), M, 3 * D, D, 128, (size_t)M * 128}; pg8::StaticOrder S; S.init(M, 3 * D, G, (int)blockIdx.x);
            EpiConvIn E{CV, CB, SSQ(1)};
            pg8::gemm_phase<EpiConvIn, pg8::StaticOrder, true, true>(lds, g, S, E);
        } else if (kind == 4) {
            conv_ew(CV, CB, CY, a.in[6]);
        } else if (kind == 5) {
            pg8::Gemm g{HB, (const bf16_t*)(ws + WS_WQKV) + (size_t)p0 * NQKVG * D, M, NQKVG, D, 128, (size_t)M * 128}; pg8::StaticOrder S; S.init(M, NQKVG, G, (int)blockIdx.x);
            bf16_t* Qb = (p0 & 1) ? (bf16_t*)(ws + WS_Q1) : R1; bf16_t* KVb = (p0 & 1) ? (bf16_t*)a.out : R1 + (size_t)16 * M * 64;
            EpiQKV E{Qb, KVb, SSQ(4), a.in[9] + p0 * 64, a.in[10] + p0 * 64, 2 * p0};
            pg8::gemm_phase<EpiQKV, pg8::StaticOrder, true, true>(lds, g, S, E);
        } else {
            const float* biasG = (const float*)(ws + WS_BIAS) + p0 * 16 * 192;
            const bf16_t* Qb = (p0 & 1) ? (const bf16_t*)(ws + WS_Q1) : R1; const bf16_t* KVb = (p0 & 1) ? (const bf16_t*)a.out : R1 + (size_t)16 * M * 64;
            attn_phase(lds, Qb, KVb, OB, LSE, biasG, p0, 2 * p0, G);
        }
        }
        if (step + 1 < a.step_hi && step != 11 && step != 13) { if (a.step_hi > 1000) cg::this_grid().sync(); else xcd_barrier(bar); }
    }
}

constexpr int NSTEPS = 19;

extern "C" void kernel_launch(void* const* d_in, const int* in_sizes, int n_in, void* d_out, int out_size, void* d_ws, size_t ws_size, hipStream_t stream) {
    static int grid = 0;
    if (grid == 0) {
        if (n_in != 16 || in_sizes[0] != M * D || out_size != M * D || ws_size < WS_END) {
            fprintf(stderr, "kernel_launch: unexpected shapes n_in %d in0 %d out %d ws %zu (need %zu)\n", n_in, n_in > 0 ? in_sizes[0] : -1, out_size, ws_size, (size_t)WS_END); grid = -1; return; }
        int dev = 0, cus = 0, per_cu = 0;
        hipGetDevice(&dev); hipDeviceGetAttribute(&cus, hipDeviceAttributeMultiprocessorCount, dev);
        if (hipFuncSetAttribute((const void*)fwd_megakernel, hipFuncAttributeMaxDynamicSharedMemorySize, LDS_BYTES) != hipSuccess) { fprintf(stderr, "kernel_launch: hipFuncSetAttribute failed\n"); grid = -1; return; }
        if (hipOccupancyMaxActiveBlocksPerMultiprocessor(&per_cu, (const void*)fwd_megakernel, NTHREADS, LDS_BYTES) != hipSuccess || per_cu < 1) { fprintf(stderr, "kernel_launch: occupancy query says %d\n", per_cu); per_cu = 1; }
        (void)hipGetLastError();
        grid = cus * 1;
        fprintf(stderr, "kernel_launch: cus %d per_cu %d grid %d\n", cus, per_cu, grid);
    }
    if (grid < 0) return;
    if (hipMemsetAsync((char*)d_ws + WS_CTL, 0, 16384, stream) != hipSuccess) { fprintf(stderr, "kernel_launch: memset failed\n"); return; }
    Args a{};
    for (int i = 0; i < 16; ++i) a.in[i] = (const float*)d_in[i];
    a.out = (float*)d_out; a.ws = (unsigned char*)d_ws;
#if MK_ONE_LAUNCH
    a.step_lo = 0; a.step_hi = NSTEPS;
    void* args[] = {&a};
    hipError_t e = hipLaunchCooperativeKernel((const void*)fwd_megakernel, dim3(grid), dim3(NTHREADS), args, LDS_BYTES, stream);
    if (e != hipSuccess) fprintf(stderr, "cooperative launch failed: %s (grid %d)\n", hipGetErrorString(e), grid);
#else
    for (int s = 0; s < NSTEPS; ++s) { a.step_lo = s; a.step_hi = s + 1; hipLaunchKernelGGL(fwd_megakernel, dim3(grid), dim3(NTHREADS), LDS_BYTES, stream, a); }
#endif
}
```
